# Optimizing an MI355X kernel written in HIP

```python
import math
import jax, jax.numpy as jnp
from jax import lax
import numpy as np

D_MODEL = 1024
BATCH = 16
SEQ = 2048
DEPTH = 4

CHUNK = 64
Q_BLOCK = 128
N_MEM = 256
EPS = 1e-6

A_HEADS = 4
A_QK_DIM = 64
A_V_DIM = 2 * A_QK_DIM
A_WIDTH = A_HEADS * A_V_DIM
REL_BUCKETS = 32
REL_MAX_DIST = 128

POOL_WINDOWS = (2, 4, 8, 16)
POOL_GROUPS = len(POOL_WINDOWS)
POOL_GROUP_DIM = 128
POOL_WIDTH = POOL_GROUPS * POOL_GROUP_DIM

SSD_HEADS = 8
SSD_HEAD_DIM = 64
SSD_WIDTH = SSD_HEADS * SSD_HEAD_DIM
SSD_GROUPS = 2
SSD_STATE = 64
SSD_CONV = 4
SSD_CONV_CH = SSD_WIDTH + 2 * SSD_GROUPS * SSD_STATE

N_BRANCH = 3

COL_Q = 0
COL_K = COL_Q + A_HEADS * 2 * A_QK_DIM
COL_V = COL_K + A_HEADS * 2 * A_QK_DIM
COL_POOL = COL_V + A_WIDTH
COL_Z = COL_POOL + POOL_WIDTH
COL_XBC = COL_Z + SSD_WIDTH
COL_DT = COL_XBC + SSD_CONV_CH
COL_GATE = COL_DT + SSD_HEADS
IN_COLS = COL_GATE + N_BRANCH * D_MODEL

X_HEADS = 4
X_HEAD_DIM = 64
X_WIDTH = X_HEADS * X_HEAD_DIM

N_EGROUPS = 4
EXPERTS_PER_GROUP = 4
N_EXPERTS = N_EGROUPS * EXPERTS_PER_GROUP
EXPERT_TOPK = 2
EXPERT_FF = 512

kernel_name = 'hybrid_diffattn_pool_ssd_hmoe_trunk'


def rmsnorm(x, g):
    xf = x.astype(jnp.float32)
    y = xf * lax.rsqrt(jnp.mean(xf * xf, axis=-1, keepdims=True) + EPS)
    return (y * g.astype(jnp.float32)).astype(x.dtype)


def rel_bucket(rel):
    nb = REL_BUCKETS // 2
    max_exact = nb // 2
    side = jnp.where(rel > 0, nb, 0)
    n = jnp.abs(rel)
    n_f = jnp.maximum(n, 1).astype(jnp.float32)
    large = max_exact + (jnp.log(n_f / max_exact) / math.log(REL_MAX_DIST / max_exact)
                         * (nb - max_exact)).astype(jnp.int32)
    large = jnp.minimum(large, nb - 1)
    return side + jnp.where(n < max_exact, n, large)


def diff_attention(q, k, v, lam, rel_table, subln_g, lam_init):
    B, S = q.shape[0], q.shape[1]
    nb = S // Q_BLOCK
    qb = (q * (A_QK_DIM ** -0.5)).reshape(B, nb, Q_BLOCK, A_HEADS, 2, A_QK_DIM)
    qb = jnp.moveaxis(qb, 1, 0)
    kpos = jnp.arange(S)

    def block(args):
        qblk, i = args
        qpos = i * Q_BLOCK + jnp.arange(Q_BLOCK)
        bias = rel_table[rel_bucket(kpos[None, :] - qpos[:, None])]
        bias = jnp.transpose(bias, (2, 0, 1)).astype(jnp.float32)
        visible = (kpos[None, :] // CHUNK) <= (qpos[:, None] // CHUNK)
        s = jnp.einsum('bqhmd,bkhmd->bhmqk', qblk, k).astype(jnp.float32)
        s = s + bias[None, :, None]
        s = jnp.where(visible, s, -jnp.inf)
        p = jax.nn.softmax(s, axis=-1)
        attn = p[:, :, 0] - lam * p[:, :, 1]
        return jnp.einsum('bhqk,bkhv->bqhv', attn.astype(v.dtype), v)

    o = lax.map(block, (qb, jnp.arange(nb)))
    o = jnp.moveaxis(o, 0, 1).reshape(B, S, A_HEADS, A_V_DIM)
    o = rmsnorm(o, subln_g) * (1.0 - lam_init)
    return o.reshape(B, S, A_WIDTH)


def pool_mixer(u, w_group, scale):
    B, S = u.shape[0], u.shape[1]
    G = POOL_GROUP_DIM
    uf = u.astype(jnp.float32)
    c = jnp.cumsum(uf, axis=1)
    t = jnp.arange(1, S + 1, dtype=jnp.float32)
    outs = []
    for gi, w in enumerate(POOL_WINDOWS):
        cg = c[..., gi * G:(gi + 1) * G]
        shifted = jnp.pad(cg, ((0, 0), (w, 0), (0, 0)))[:, :S]
        mean = (cg - shifted) / jnp.minimum(t, float(w))[None, :, None]
        outs.append(mean - uf[..., gi * G:(gi + 1) * G])
    d = jnp.stack(outs, axis=2).astype(u.dtype)
    y = jnp.einsum('bsgc,gcd->bsgd', d, w_group)
    return y.reshape(B, S, POOL_WIDTH) * scale


def ssd_chunked(xs, dt, A, Bm, Cm):
    Bsz, S, H, P = xs.shape
    N = Bm.shape[-1]
    nc = S // CHUNK
    x_ = xs.reshape(Bsz, nc, CHUNK, H, P)
    dt_ = dt.reshape(Bsz, nc, CHUNK, H)
    B_ = Bm.reshape(Bsz, nc, CHUNK, H, N)
    C_ = Cm.reshape(Bsz, nc, CHUNK, H, N)
    dA_cs = jnp.cumsum(dt_ * A, axis=2)
    seg = dA_cs[:, :, :, None, :] - dA_cs[:, :, None, :, :]
    causal = jnp.tril(jnp.ones((CHUNK, CHUNK), dtype=bool))[None, None, :, :, None]
    Lmat = jnp.exp(jnp.where(causal, seg, -jnp.inf))
    xdt = x_ * dt_[..., None]
    scores = jnp.einsum('bclhn,bcshn->bclsh', C_, B_)
    y_diag = jnp.einsum('bclsh,bcshp->bclhp', scores * Lmat, xdt)
    decay_to_end = jnp.exp(dA_cs[:, :, -1:, :] - dA_cs)
    states = jnp.einsum('bclhn,bclh,bclhp->bchpn', B_, decay_to_end, xdt)
    chunk_decay = jnp.exp(dA_cs[:, :, -1, :])

    def step(h, inp):
        st, dec = inp
        return h * dec[..., None, None] + st, h

    h0 = jnp.zeros((Bsz, H, P, N), dtype=xs.dtype)
    _, h_in = lax.scan(step, h0, (jnp.moveaxis(states, 1, 0), jnp.moveaxis(chunk_decay, 1, 0)))
    h_in = jnp.moveaxis(h_in, 0, 1)
    y_off = jnp.einsum('bclhn,bchpn,bclh->bclhp', C_, h_in, jnp.exp(dA_cs))
    return (y_diag + y_off).reshape(Bsz, S, H, P)


def ssd_mixer(z, xbc, dt_raw, conv_w, conv_b, dt_bias, A_log, D_skip, norm_g):
    B, S = z.shape[0], z.shape[1]
    xbc = lax.conv_general_dilated(xbc, conv_w[:, None, :], window_strides=(1,),
                                   padding=[(SSD_CONV - 1, 0)],
                                   dimension_numbers=('NWC', 'WIO', 'NWC'),
                                   feature_group_count=SSD_CONV_CH) + conv_b
    xbc = jax.nn.silu(xbc)
    GN = SSD_GROUPS * SSD_STATE
    xs = xbc[..., :SSD_WIDTH].reshape(B, S, SSD_HEADS, SSD_HEAD_DIM).astype(jnp.float32)
    Bm = xbc[..., SSD_WIDTH:SSD_WIDTH + GN].reshape(B, S, SSD_GROUPS, SSD_STATE)
    Cm = xbc[..., SSD_WIDTH + GN:].reshape(B, S, SSD_GROUPS, SSD_STATE)
    rep = SSD_HEADS // SSD_GROUPS
    Bm = jnp.repeat(Bm, rep, axis=2).astype(jnp.float32)
    Cm = jnp.repeat(Cm, rep, axis=2).astype(jnp.float32)
    dt = jax.nn.softplus(dt_raw.astype(jnp.float32) + dt_bias.astype(jnp.float32))
    A = -jnp.exp(A_log.astype(jnp.float32))
    y = ssd_chunked(xs, dt, A, Bm, Cm)
    y = y + D_skip.astype(jnp.float32)[:, None] * xs
    y = y.reshape(B, S, SSD_WIDTH) * jax.nn.silu(z.astype(jnp.float32))
    return rmsnorm(y.astype(z.dtype), norm_g)


def mem_cross_attention(h, mem_n, w_q, w_kv, w_o):
    B, S = h.shape[0], h.shape[1]
    M = mem_n.shape[1]
    q = (h @ w_q).reshape(B, S, X_HEADS, X_HEAD_DIM) * (X_HEAD_DIM ** -0.5)
    kv = mem_n @ w_kv
    k = kv[..., :X_WIDTH].reshape(B, M, X_HEADS, X_HEAD_DIM)
    v = kv[..., X_WIDTH:].reshape(B, M, X_HEADS, X_HEAD_DIM)
    s = jnp.einsum('bshd,bmhd->bhsm', q, k).astype(jnp.float32)
    p = jax.nn.softmax(s, axis=-1).astype(v.dtype)
    o = jnp.einsum('bhsm,bmhd->bshd', p, v).reshape(B, S, X_WIDTH)
    return o @ w_o


def hierarchical_moe(h, w_rg, b_rg, w_re, b_re, w_gate, w_up, w_down):
    B, S, D = h.shape
    hf = h.reshape(B * S, D)
    g_prob = jax.nn.softmax((hf @ w_rg).astype(jnp.float32) + b_rg.astype(jnp.float32), axis=-1)
    g_p, g_idx = lax.top_k(g_prob, 1)
    e_logits = ((hf @ w_re).astype(jnp.float32) + b_re.astype(jnp.float32))
    e_logits = e_logits.reshape(-1, N_EGROUPS, EXPERTS_PER_GROUP)
    g_onehot = jax.nn.one_hot(g_idx[:, 0], N_EGROUPS, dtype=jnp.float32)
    e_in = jnp.sum(e_logits * g_onehot[:, :, None], axis=1)
    e_val, e_idx = lax.top_k(e_in, EXPERT_TOPK)
    e_w = jax.nn.softmax(e_val, axis=-1)
    expert_id = g_idx * EXPERTS_PER_GROUP + e_idx
    comb = g_p * e_w
    comb_dense = jnp.sum(jax.nn.one_hot(expert_id, N_EXPERTS, dtype=jnp.float32) * comb[..., None], axis=1)
    comb_dense = comb_dense.astype(h.dtype)
    y = jnp.zeros_like(hf)
    for e in range(N_EXPERTS):
        a = jax.nn.silu(hf @ w_gate[e]) * (hf @ w_up[e])
        y = y + comb_dense[:, e:e + 1] * (a @ w_down[e])
    return y.reshape(B, S, D)


def setup_inputs(seed: int = 0) -> dict:
    key = jax.random.key(seed)
    ks = iter(jax.random.split(key, 48))
    f32 = jnp.float32
    nrm = lambda shape, s: jax.random.normal(next(ks), shape, f32) * s
    gain = lambda shape: 1.0 + 0.02 * jax.random.normal(next(ks), shape, f32)
    Dm = D_MODEL
    dt0 = jnp.exp(jax.random.uniform(next(ks), (DEPTH, SSD_HEADS), f32,
                                     math.log(1e-3), math.log(1e-1)))
    dt_bias = dt0 + jnp.log(-jnp.expm1(-dt0))
    A_log = jnp.log(jax.random.uniform(next(ks), (DEPTH, SSD_HEADS), f32, 1.0, 16.0))
    return {
        'x': nrm((BATCH, SEQ, Dm), 1.0),
        'mem': nrm((BATCH, N_MEM, Dm), 1.0),
        'w_in': nrm((DEPTH, Dm, IN_COLS), Dm ** -0.5),
        'b_gate': nrm((DEPTH, N_BRANCH * Dm), 0.02),
        'lam_q1': nrm((DEPTH, A_QK_DIM), 0.1),
        'lam_k1': nrm((DEPTH, A_QK_DIM), 0.1),
        'lam_q2': nrm((DEPTH, A_QK_DIM), 0.1),
        'lam_k2': nrm((DEPTH, A_QK_DIM), 0.1),
        'attn_subln_g': gain((DEPTH, A_V_DIM)),
        'rel_bias_table': nrm((REL_BUCKETS, A_HEADS), 0.2),
        'w_pool_group': nrm((DEPTH, POOL_GROUPS, POOL_GROUP_DIM, POOL_GROUP_DIM), POOL_GROUP_DIM ** -0.5),
        'pool_scale': 1.0 + 0.1 * jax.random.normal(next(ks), (DEPTH, POOL_WIDTH), f32),
        'ssd_conv_w': nrm((DEPTH, SSD_CONV, SSD_CONV_CH), SSD_CONV ** -0.5),
        'ssd_conv_b': nrm((DEPTH, SSD_CONV_CH), 0.02),
        'ssd_dt_bias': dt_bias,
        'ssd_A_log': A_log,
        'ssd_D': gain((DEPTH, SSD_HEADS)),
        'ssd_norm_g': gain((DEPTH, SSD_WIDTH)),
        'w_branch': nrm((DEPTH, N_BRANCH, A_WIDTH, Dm), A_WIDTH ** -0.5),
        'w_mix_out': nrm((DEPTH, Dm, Dm), Dm ** -0.5),
        'g_mix': gain((DEPTH, Dm)),
        'g_xattn': gain((DEPTH, Dm)),
        'g_mem': gain((DEPTH, Dm)),
        'w_xq': nrm((DEPTH, Dm, X_WIDTH), Dm ** -0.5),
        'w_xkv': nrm((DEPTH, Dm, 2 * X_WIDTH), Dm ** -0.5),
        'w_xo': nrm((DEPTH, X_WIDTH, Dm), X_WIDTH ** -0.5),
        'g_moe': gain((DEPTH, Dm)),
        'w_router_group': nrm((DEPTH, Dm, N_EGROUPS), Dm ** -0.5),
        'b_router_group': nrm((DEPTH, N_EGROUPS), 0.01),
        'w_router_expert': nrm((DEPTH, Dm, N_EXPERTS), Dm ** -0.5),
        'b_router_expert': nrm((DEPTH, N_EXPERTS), 0.01),
        'w_exp_gate': nrm((DEPTH, N_EXPERTS, Dm, EXPERT_FF), Dm ** -0.5),
        'w_exp_up': nrm((DEPTH, N_EXPERTS, Dm, EXPERT_FF), Dm ** -0.5),
        'w_exp_down': nrm((DEPTH, N_EXPERTS, EXPERT_FF, Dm), EXPERT_FF ** -0.5),
        'g_final': gain((Dm,)),
    }


def reference(x, mem, w_in, b_gate, lam_q1, lam_k1, lam_q2, lam_k2, attn_subln_g,
              rel_bias_table, w_pool_group, pool_scale, ssd_conv_w, ssd_conv_b,
              ssd_dt_bias, ssd_A_log, ssd_D, ssd_norm_g, w_branch, w_mix_out,
              g_mix, g_xattn, g_mem, w_xq, w_xkv, w_xo, g_moe,
              w_router_group, b_router_group, w_router_expert, b_router_expert,
              w_exp_gate, w_exp_up, w_exp_down, g_final):
    B, S, Dm = x.shape
    for l in range(DEPTH):
        lam_init = 0.8 - 0.6 * math.exp(-0.3 * l)
        h = rmsnorm(x, g_mix[l])
        proj = h @ w_in[l]
        q = proj[..., COL_Q:COL_K].reshape(B, S, A_HEADS, 2, A_QK_DIM)
        k = proj[..., COL_K:COL_V].reshape(B, S, A_HEADS, 2, A_QK_DIM)
        v = proj[..., COL_V:COL_POOL].reshape(B, S, A_HEADS, A_V_DIM)
        lam = (jnp.exp(jnp.sum(lam_q1[l].astype(jnp.float32) * lam_k1[l].astype(jnp.float32)))
               - jnp.exp(jnp.sum(lam_q2[l].astype(jnp.float32) * lam_k2[l].astype(jnp.float32)))
               + lam_init)
        o_a = diff_attention(q, k, v, lam, rel_bias_table, attn_subln_g[l], lam_init)
        o_b = pool_mixer(proj[..., COL_POOL:COL_Z], w_pool_group[l], pool_scale[l])
        o_c = ssd_mixer(proj[..., COL_Z:COL_XBC], proj[..., COL_XBC:COL_DT],
                        proj[..., COL_DT:COL_GATE], ssd_conv_w[l], ssd_conv_b[l],
                        ssd_dt_bias[l], ssd_A_log[l], ssd_D[l], ssd_norm_g[l])
        gates = jax.nn.sigmoid(proj[..., COL_GATE:] + b_gate[l]).reshape(B, S, N_BRANCH, Dm)
        merged = (gates[:, :, 0] * (o_a @ w_branch[l, 0])
                  + gates[:, :, 1] * (o_b @ w_branch[l, 1])
                  + gates[:, :, 2] * (o_c @ w_branch[l, 2]))
        x = x + merged @ w_mix_out[l]
        mem_n = rmsnorm(mem, g_mem[l])
        x = x + mem_cross_attention(rmsnorm(x, g_xattn[l]), mem_n, w_xq[l], w_xkv[l], w_xo[l])
        x = x + hierarchical_moe(rmsnorm(x, g_moe[l]), w_router_group[l], b_router_group[l],
                                 w_router_expert[l], b_router_expert[l],
                                 w_exp_gate[l], w_exp_up[l], w_exp_down[l])
    return rmsnorm(x, g_final)
```

```cpp
#include <hip/hip_runtime.h>
#include <cstdio>
#include <cstdint>
#include <cstring>

#define LAS __attribute__((address_space(3)))
#define GAS __attribute__((address_space(1)))
typedef unsigned short bf16_t;
typedef short bf16x8 __attribute__((ext_vector_type(8)));
typedef short s16x4 __attribute__((ext_vector_type(4)));
typedef float f32x2 __attribute__((ext_vector_type(2)));
typedef float f32x4 __attribute__((ext_vector_type(4)));
typedef float f32x16 __attribute__((ext_vector_type(16)));
typedef unsigned u32x2 __attribute__((ext_vector_type(2)));
typedef unsigned u32x4 __attribute__((ext_vector_type(4)));

constexpr int DM = 1024, BATCH = 16, SEQ = 2048, T = BATCH * SEQ, DEPTH = 4, NMEM = 256;
constexpr int IN_COLS = 6408, COL_DT = 3328, COL_GATE = 3336;
constexpr int PC = 6400;
constexpr int PQ = 0, PK = 512, PV = 1024, PU = 1536, PZ = 2048, PX = 2560, PG = 3328;
constexpr float EPS = 1e-6f;
constexpr float LOG2E = 1.4426950408889634f;
constexpr int NWAVES = 8, NTHR = 512;

constexpr size_t MiB = 1u << 20;
constexpr size_t WS_CTL = 0, CTL_BYTES = 1 * MiB;
constexpr size_t WS_W = 1 * MiB;
constexpr size_t W_IN = 0;
constexpr size_t W_XKV = W_IN + (size_t)6400 * 1024 * 2;
constexpr size_t W_BR = W_XKV + (size_t)512 * 1024 * 2;
constexpr size_t W_MIX = W_BR + (size_t)3 * 1024 * 512 * 2;
constexpr size_t W_XQ = W_MIX + (size_t)1024 * 1024 * 2;
constexpr size_t W_XO = W_XQ + (size_t)256 * 1024 * 2;
constexpr size_t W_GU = W_XO + (size_t)1024 * 256 * 2;
constexpr size_t W_DN = W_GU + (size_t)16 * 1024 * 1024 * 2;
constexpr size_t W_END = W_DN + (size_t)16 * 1024 * 512 * 2;
constexpr size_t WS_H = WS_W + 68 * MiB;
constexpr size_t WS_MEMN = WS_H + (size_t)T * DM * 2;
constexpr size_t WS_PROJ = WS_MEMN + (size_t)4096 * DM * 2;
constexpr size_t WS_STATES = WS_PROJ + (size_t)T * PC * 2;
constexpr size_t WS_DT = WS_STATES + (size_t)64 * MiB;
constexpr size_t WS_SSQ = WS_DT + 1 * MiB;
constexpr size_t WS_DEC = WS_SSQ + 1 * MiB;
constexpr size_t WS_KV = WS_DEC + 1 * MiB;
constexpr size_t WS_LIST = WS_KV + 4 * MiB;
constexpr size_t WS_LW = WS_LIST + (size_t)24 * T * 4;
constexpr size_t WS_END = WS_LW + (size_t)24 * T * 8;
static_assert(W_END <= 68 * MiB, "weights region");
constexpr size_t WS_XQ = WS_PROJ;
constexpr size_t WS_XO = WS_PROJ + 16 * MiB;
constexpr size_t WS_AMOE = WS_PROJ;

constexpr int CW_BAR = 1024;
constexpr int CW_CNT = 8192;

constexpr int RING_BYTES = 155648;
constexpr int MISC_OFF = RING_BYTES;
constexpr int LDS_BYTES = 163840;

__device__ __forceinline__ unsigned f2bf(float f) { unsigned u = __builtin_bit_cast(unsigned, f); return (u + 0x7fffu + ((u >> 16) & 1u)) >> 16; }
__device__ __forceinline__ unsigned pk2(float lo, float hi) { typedef __bf16 bf2 __attribute__((ext_vector_type(2))); f32x2 v = {lo, hi}; bf2 b = __builtin_convertvector(v, bf2); return __builtin_bit_cast(unsigned, b); }
__device__ __forceinline__ float bf_lo(unsigned w) { return __builtin_bit_cast(float, w << 16); }
__device__ __forceinline__ float bf_hi(unsigned w) { return __builtin_bit_cast(float, w & 0xffff0000u); }
__device__ __forceinline__ float bf2f(bf16_t b) { return __builtin_bit_cast(float, ((unsigned)b) << 16); }
__device__ __forceinline__ float wave_sum(float v) {
#pragma unroll
    for (int o = 1; o < 64; o <<= 1) v += __shfl_xor(v, o);
    return v;
}
__device__ __forceinline__ float sigmoidf_(float x) { return 1.0f / (1.0f + __expf(-x)); }
__device__ __forceinline__ float siluf_(float x) { return x / (1.0f + __expf(-x)); }
#define LDS_WAIT() asm volatile("s_waitcnt lgkmcnt(0)" ::: "memory")
#define VM_WAIT() asm volatile("s_waitcnt vmcnt(0)" ::: "memory")

#define XB_TMO      128
#define XB_XCNT(j)  (256  + 64 * (j))
#define XB_XSUB(j)  (1280 + 64 * (j))
#define XB_XGEN(j)  (2304 + 64 * (j))
#define XB_TOP      3328
#define XB_TOPGEN   3392
#define XCD_BAR_WORDS 3456
#define XB_SPIN_CAP (1u << 18)
__device__ __forceinline__ unsigned xb_ld(unsigned* p)              { return __hip_atomic_load(p, __ATOMIC_RELAXED, __HIP_MEMORY_SCOPE_AGENT); }
__device__ __forceinline__ unsigned xb_add(unsigned* p, unsigned v) { return __hip_atomic_fetch_add(p, v, __ATOMIC_RELAXED, __HIP_MEMORY_SCOPE_AGENT); }
__device__ __forceinline__ unsigned xb_xcc_id() { return (unsigned)__builtin_amdgcn_s_getreg((3 << 11) | 20) & 0xFu; }
#define XB_SPIN(cond, bar) do { unsigned _sp = 0; while (cond) { __builtin_amdgcn_s_sleep(1); \
    if ((++_sp & 255u) == 0u) { if (xb_ld(&(bar)[XB_TMO])) break; if (_sp > XB_SPIN_CAP) { atomicAdd(&(bar)[XB_TMO], 1u); break; } } } } while (0)
struct XcdBarrier { unsigned* bar; unsigned x; volatile LAS unsigned* st; };
__device__ __forceinline__ XcdBarrier xcd_barrier_post(unsigned* bar, volatile LAS unsigned* st) {
    XcdBarrier b; b.bar = bar; b.x = xb_xcc_id(); b.st = st;
    if (threadIdx.x == 0) (void)xb_add(&bar[XB_XCNT(b.x)], 1u);
    return b;
}
__device__ __forceinline__ void xcd_barrier_complete(unsigned* bar, unsigned x, unsigned& nloc, unsigned& nx) {
    const unsigned G = gridDim.x * gridDim.y * gridDim.z;
    unsigned sum, cnt, mine, sp = 0u;
    for (;;) {
        sum = 0u; cnt = 0u; mine = 0u;
#pragma unroll
        for (unsigned j = 0; j < 16; ++j) { const unsigned c = xb_ld(&bar[XB_XCNT(j)]); sum += c; cnt += (c > 0u) ? 1u : 0u; mine = (j == x) ? c : mine; }
        if (sum == G) break;
        __builtin_amdgcn_s_sleep(1);
        if ((++sp & 255u) == 0u) { if (xb_ld(&bar[XB_TMO])) break; if (sp > XB_SPIN_CAP) { atomicAdd(&bar[XB_TMO], 1u); break; } }
    }
    nloc = mine > 0u ? mine : 1u; nx = cnt > 0u ? cnt : 1u;
}
__device__ __forceinline__ void xcd_barrier(const XcdBarrier& b) {
    asm volatile("s_waitcnt vmcnt(0)" ::: "memory");
    __syncthreads();
    if (threadIdx.x == 0) {
        unsigned* bar = b.bar;
        __builtin_amdgcn_s_waitcnt(0);
        unsigned nloc = b.st[0], nx = b.st[1];
        if (nloc == 0u) { xcd_barrier_complete(bar, b.x, nloc, nx); b.st[0] = nloc; b.st[1] = nx; }
        const unsigned old = xb_add(&bar[XB_XSUB(b.x)], 1u);
        const unsigned gen = old / nloc;
        if (old + 1u == (gen + 1u) * nloc) {
            __builtin_amdgcn_fence(__ATOMIC_RELEASE, "agent");
            asm volatile("s_waitcnt vmcnt(0)" ::: "memory");
            const unsigned og = xb_add(&bar[XB_TOP], 1u);
            const unsigned tg = og / nx;
            if (og + 1u == (tg + 1u) * nx) xb_add(&bar[XB_TOPGEN], 1u);
            else XB_SPIN(xb_ld(&bar[XB_TOPGEN]) == tg, bar);
            __builtin_amdgcn_fence(__ATOMIC_ACQUIRE, "agent");
            xb_add(&bar[XB_XGEN(b.x)], 1u);
            asm volatile("s_waitcnt vmcnt(0)" ::: "memory");
        } else {
            XB_SPIN(xb_ld(&bar[XB_XGEN(b.x)]) == gen, bar);
            __builtin_amdgcn_fence(__ATOMIC_ACQUIRE, "agent");
            asm volatile("s_waitcnt vmcnt(0)" ::: "memory");
        }
    }
    __syncthreads();
}

namespace pg8 {
constexpr int BM = 256, BK = 64, HALF = 128, HTB = HALF * BK * 2, STAGE_BYTES = 8 * HTB, NXCD = 8, WGM = 8;
__device__ __forceinline__ int lds_byte(int r, int c) { const int st = (r >> 4) * 2 + (c >> 5), rr = r & 15, cc = c & 31, ob = rr * 64 + cc * 2; return st * 1024 + (ob ^ (((ob >> 9) & 1) << 5)); }
__device__ __forceinline__ void stage_rc(int b, int& R, int& C) { const int st = b / 1024, sb = b % 1024, swz = sb ^ (((sb >> 9) & 1) << 5); R = (st >> 1) * 16 + swz / 64; C = (st & 1) * 32 + (swz % 64) / 2; }
__device__ __forceinline__ int perm32(int rho) { const int n = rho >> 4, i = rho & 15; return 8 * (i >> 2) + 4 * n + (i & 3); }
struct Unit { int pm, pn, x0, x1; };
__device__ __forceinline__ void tile_of(int L, int nM, int nN, int& pm, int& pn) {
    const int nwg = nM * nN; int wgid = L; { const int q = nwg / NXCD, r = nwg % NXCD, xcd = wgid % NXCD, off = wgid / NXCD; wgid = (xcd < r ? xcd * (q + 1) : r * (q + 1) + (xcd - r) * q) + off; }
    const int nig = WGM * nN, gid = wgid / nig, fm = gid * WGM, gsz = (nM - fm) < WGM ? (nM - fm) : WGM;
    pm = fm + ((wgid % nig) % gsz); pn = (wgid % nig) / gsz;
}
struct PlainProb {
    static constexpr bool GATHER = false;
    const char* A; const char* Bt; unsigned lda2, ldb2; int nM, nN, G, c;
    __device__ __forceinline__ bool next(int i, Unit& u) const { const long L = (long)i * G + c; if (L >= (long)nM * nN) return false; tile_of((int)L, nM, nN, u.pm, u.pn); u.x0 = 0; u.x1 = 0; return true; }
    __device__ __forceinline__ const char* a_base(const Unit& u, int t) const { return A + (size_t)u.pm * 256 * lda2 + (size_t)t * 128; }
    __device__ __forceinline__ unsigned a_off(const Unit&, int half, int R, int C) const { return (unsigned)(half * 128 + R) * lda2 + (unsigned)C * 2u; }
    __device__ __forceinline__ const char* b_base(const Unit& u, int t) const { return Bt + (size_t)u.pn * 256 * ldb2 + (size_t)t * 128; }
};

typedef float f32x4_ __attribute__((ext_vector_type(4)));
template <class Epi, class Prob, bool ALIGN_EPI>
__device__ __forceinline__ void gemm_phase(LAS unsigned char* lds, const int tid, const Prob& P, const Epi& E, const int nt) {
    const int wid = __builtin_amdgcn_readfirstlane(tid >> 6), lane = tid & 63, wr = wid >> 2, wc = wid & 3, fr = lane & 15, fq = lane >> 4;
    int Rs[2], Cs[2]; unsigned voffB[2];
#pragma unroll
    for (int i = 0; i < 2; ++i) { stage_rc(tid * 16 + i * 8192, Rs[i], Cs[i]); const int Rb = Epi::PERM ? ((Rs[i] & ~31) + perm32(Rs[i] & 31)) : Rs[i]; voffB[i] = (unsigned)Rb * P.ldb2 + (unsigned)Cs[i] * 2u; }
    const unsigned hstepB = 128u * P.ldb2;
    const unsigned ldsw = (unsigned)wid * 1024u;
    const int aoff = lds_byte(wr * 64 + fr, fq * 8), boff = lds_byte(wc * 32 + fr, fq * 8);
#define PG8_SA(b, h) (((b) * 2 + (h)) * HTB)
#define PG8_SB(b, h) ((4 + (b) * 2 + (h)) * HTB)
#define PG8_STAGE(bufoff, gbase, voff) do { _Pragma("unroll") for (int _i = 0; _i < 2; ++_i) \
        __builtin_amdgcn_global_load_lds((const unsigned*)((const char*)(gbase) + (voff)[_i]), (LAS unsigned*)(lds + (bufoff) + ldsw + _i * 8192), 16, 0, 0); } while (0)
#define PG8_LDA(dst, b, h) do { _Pragma("unroll") for (int m = 0; m < 4; ++m) _Pragma("unroll") for (int k = 0; k < 2; ++k) dst[m][k] = *(const LAS bf16x8*)(lds + PG8_SA(b, h) + aoff + m * 2048 + k * 1024); } while (0)
#define PG8_LDB(dst, b, h) do { _Pragma("unroll") for (int n = 0; n < 2; ++n) _Pragma("unroll") for (int k = 0; k < 2; ++k) dst[n][k] = *(const LAS bf16x8*)(lds + PG8_SB(b, h) + boff + n * 2048 + k * 1024); } while (0)
#define PG8_MMA(ai, bj, At, Bt) do { __builtin_amdgcn_s_setprio(1); _Pragma("unroll") for (int m = 0; m < 4; ++m) _Pragma("unroll") for (int n = 0; n < 2; ++n) _Pragma("unroll") for (int k = 0; k < 2; ++k) \
        acc[ai][bj][m][n] = __builtin_amdgcn_mfma_f32_16x16x32_bf16(Bt[n][k], At[m][k], acc[ai][bj][m][n], 0, 0, 0); __builtin_amdgcn_s_setprio(0); } while (0)
#define PG8_WAIT_V(n) asm volatile("s_waitcnt vmcnt(" #n ")" ::: "memory")
#define PG8_WAIT_L(n) asm volatile("s_waitcnt lgkmcnt(" #n ")" ::: "memory")
#define PG8_BAR __builtin_amdgcn_s_barrier()
#define PG8_SCHED __builtin_amdgcn_sched_barrier(0)
    Unit cur, nxt; int ui = 0;
    if (!P.next(0, cur)) return;
    f32x4 acc[2][2][4][2];
#pragma unroll
    for (int a = 0; a < 2; ++a)
#pragma unroll
        for (int b = 0; b < 2; ++b)
#pragma unroll
            for (int m = 0; m < 4; ++m)
#pragma unroll
                for (int n = 0; n < 2; ++n) acc[a][b][m][n] = (f32x4){0.f, 0.f, 0.f, 0.f};
    bf16x8 At[4][2], B0[2][2], B1[2][2];
    unsigned cA0[2], cA1[2], nA0[2], nA1[2];
#pragma unroll
    for (int i = 0; i < 2; ++i) { cA0[i] = P.a_off(cur, 0, Rs[i], Cs[i]); cA1[i] = P.a_off(cur, 1, Rs[i], Cs[i]); nA0[i] = cA0[i]; nA1[i] = cA1[i]; }
    { const char* a0 = P.a_base(cur, 0); const char* b0 = P.b_base(cur, 0); const char* a1p = P.a_base(cur, 1); const char* b1p = P.b_base(cur, 1);
      PG8_STAGE(PG8_SB(0, 0), b0, voffB); PG8_STAGE(PG8_SB(0, 1), b0 + hstepB, voffB); PG8_STAGE(PG8_SA(0, 0), a0, cA0); PG8_STAGE(PG8_SA(0, 1), a0, cA1);
      if (wr == 1) PG8_BAR;
      PG8_WAIT_V(2); PG8_BAR;
      PG8_STAGE(PG8_SB(1, 0), b1p, voffB); PG8_STAGE(PG8_SA(1, 0), a1p, cA0); PG8_STAGE(PG8_SB(1, 1), b1p + hstepB, voffB);
      PG8_WAIT_V(6); PG8_BAR; }
    for (;;) {
        const bool has_next = P.next(ui + 1, nxt);
        if (!has_next) nxt = cur;
        if constexpr (Prob::GATHER) {
#pragma unroll
            for (int i = 0; i < 2; ++i) { nA0[i] = P.a_off(nxt, 0, Rs[i], Cs[i]); nA1[i] = P.a_off(nxt, 1, Rs[i], Cs[i]); } }
        for (int t = 0; t < nt; t += 2) {
            const bool last = (t == nt - 2);
            const char* a1 = P.a_base(cur, t + 1);
            const char* a2 = last ? P.a_base(nxt, 0) : P.a_base(cur, t + 2); const char* b2 = last ? P.b_base(nxt, 0) : P.b_base(cur, t + 2);
            const char* a3 = last ? P.a_base(nxt, 1) : P.a_base(cur, t + 3); const char* b3 = last ? P.b_base(nxt, 1) : P.b_base(cur, t + 3);
            unsigned xA0[2], xA1[2];
#pragma unroll
            for (int i = 0; i < 2; ++i) { xA0[i] = (Prob::GATHER && last) ? nA0[i] : cA0[i]; xA1[i] = (Prob::GATHER && last) ? nA1[i] : cA1[i]; }
            PG8_LDB(B0, 0, 0); PG8_LDB(B1, 0, 1); PG8_SCHED; PG8_LDA(At, 0, 0); PG8_STAGE(PG8_SA(1, 1), a1, cA1);
            PG8_WAIT_V(8); PG8_WAIT_L(0); PG8_BAR; PG8_MMA(0, 0, At, B0); PG8_MMA(0, 1, At, B1); PG8_BAR; PG8_SCHED;
            PG8_LDA(At, 0, 1); PG8_STAGE(PG8_SB(0, 0), b2, voffB); PG8_STAGE(PG8_SB(0, 1), b2 + hstepB, voffB); PG8_STAGE(PG8_SA(0, 0), a2, xA0);
            PG8_WAIT_V(8); PG8_WAIT_L(0); PG8_BAR; PG8_MMA(1, 0, At, B0); PG8_MMA(1, 1, At, B1); PG8_BAR; PG8_SCHED;
            PG8_LDB(B0, 1, 0); PG8_LDB(B1, 1, 1); PG8_SCHED; PG8_LDA(At, 1, 0); PG8_STAGE(PG8_SA(0, 1), a2, xA1);
            PG8_WAIT_V(8); PG8_WAIT_L(0); PG8_BAR; PG8_MMA(0, 0, At, B0); PG8_MMA(0, 1, At, B1); PG8_BAR; PG8_SCHED;
            PG8_LDA(At, 1, 1); PG8_STAGE(PG8_SB(1, 0), b3, voffB); PG8_STAGE(PG8_SB(1, 1), b3 + hstepB, voffB); PG8_STAGE(PG8_SA(1, 0), a3, xA0);
            PG8_WAIT_V(8); PG8_WAIT_L(0); PG8_BAR; PG8_MMA(1, 0, At, B0); PG8_MMA(1, 1, At, B1); PG8_BAR; PG8_SCHED;
        }
        if constexpr (ALIGN_EPI) { if (wr == 0) PG8_BAR; }
        E(acc, cur, wr, wc, fr, fq);
        if (!has_next) break;
#pragma unroll
        for (int a = 0; a < 2; ++a)
#pragma unroll
            for (int b = 0; b < 2; ++b)
#pragma unroll
                for (int m = 0; m < 4; ++m)
#pragma unroll
                    for (int n = 0; n < 2; ++n) acc[a][b][m][n] = (f32x4){0.f, 0.f, 0.f, 0.f};
        cur = nxt; ++ui;
        if constexpr (Prob::GATHER) {
#pragma unroll
            for (int i = 0; i < 2; ++i) { cA0[i] = nA0[i]; cA1[i] = nA1[i]; } }
        if constexpr (ALIGN_EPI) { if (wr == 1) PG8_BAR; }
    }
    PG8_WAIT_V(0);
    if constexpr (!ALIGN_EPI) { if (wr == 0) PG8_BAR; }
    PG8_BAR;
#undef PG8_SA
#undef PG8_SB
#undef PG8_STAGE
#undef PG8_LDA
#undef PG8_LDB
#undef PG8_MMA
#undef PG8_WAIT_V
#undef PG8_WAIT_L
#undef PG8_BAR
#undef PG8_SCHED
}

struct EpiStore {
    static constexpr bool PERM = true;
    bf16_t* O; int ldc; int gate_pn0; const float* gbias; int gate_col0;
    __device__ __forceinline__ void operator()(const f32x4 (&acc)[2][2][4][2], const Unit& u, int wr, int wc, int fr, int fq) const {
        const int row0 = u.pm * BM + wr * 64 + fr, col0 = u.pn * BM + wc * 32 + 8 * fq;
        const bool gate = u.pn >= gate_pn0;
        f32x4 bv[2][2];
#pragma unroll
        for (int bj = 0; bj < 2; ++bj)
#pragma unroll
            for (int n = 0; n < 2; ++n) bv[bj][n] = gate ? *(const f32x4*)(gbias + (col0 - gate_col0) + bj * HALF + 4 * n) : (f32x4){0.f, 0.f, 0.f, 0.f};
#pragma unroll
        for (int ai = 0; ai < 2; ++ai)
#pragma unroll
            for (int m = 0; m < 4; ++m) { bf16_t* rowp = O + (size_t)(row0 + ai * HALF + m * 16) * ldc + col0;
#pragma unroll
                for (int bj = 0; bj < 2; ++bj) { f32x4 v0 = acc[ai][bj][m][0] + bv[bj][0], v1 = acc[ai][bj][m][1] + bv[bj][1];
                    if (gate) {
#pragma unroll
                        for (int j = 0; j < 4; ++j) { v0[j] = sigmoidf_(v0[j]); v1[j] = sigmoidf_(v1[j]); } }
                    u32x4 w; w.x = pk2(v0[0], v0[1]); w.y = pk2(v0[2], v0[3]); w.z = pk2(v1[0], v1[1]); w.w = pk2(v1[2], v1[3]);
                    *(u32x4*)(rowp + bj * HALF) = w; } }
    }
};
struct EpiResid {
    static constexpr bool PERM = false;
    const float* xin; float* out; int ldc;
    __device__ __forceinline__ void operator()(const f32x4 (&acc)[2][2][4][2], const Unit& u, int wr, int wc, int fr, int fq) const {
        const int row0 = u.pm * BM + wr * 64 + fr, col0 = u.pn * BM + wc * 32 + 4 * fq;
#pragma unroll
        for (int ai = 0; ai < 2; ++ai)
#pragma unroll
            for (int m = 0; m < 4; ++m) { const size_t off = (size_t)(row0 + ai * HALF + m * 16) * ldc + col0;
#pragma unroll
                for (int bj = 0; bj < 2; ++bj)
#pragma unroll
                    for (int n = 0; n < 2; ++n) { const f32x4 bs = *(const f32x4*)(xin + off + bj * HALF + n * 16); *(f32x4*)(out + off + bj * HALF + n * 16) = bs + acc[ai][bj][m][n]; } }
    }
};
}
struct Args { const float* in[35]; float* out; unsigned char* ws; int s_lo, s_hi; };
#define AS4 __attribute__((address_space(4)))
struct InProxy { const AS4 unsigned char* ka; __device__ __forceinline__ const float* operator[](int k) const { return *(const float* const AS4*)(ka + 8 * k); } };
struct ArgsV { InProxy in; float* out; unsigned char* ws; };
struct Frame {
    LAS unsigned char* lds;
    int tid, lane, wave, vcu, G;
};

__device__ __forceinline__ void tr_item(const float* src, int ld, int col0, bf16_t* dst, int dld, int drow0, int k0, int n0, float scale, const float* kscale, LAS float* scr, int lane) {
#pragma unroll 8
    for (int i = 0; i < 32; ++i) { const int kk = 2 * i + (lane >> 5); scr[kk * 33 + (lane & 31)] = src[(size_t)(k0 + kk) * ld + col0 + n0 + (lane & 31)]; }
    LDS_WAIT(); asm volatile("" ::: "memory");
    const int c = lane & 7;
    float ks[8];
#pragma unroll
    for (int q = 0; q < 8; ++q) ks[q] = kscale ? kscale[k0 + 8 * c + q] * scale : scale;
#pragma unroll
    for (int j = 0; j < 4; ++j) { const int n = (lane >> 3) + 8 * j; const LAS float* s = scr + (8 * c) * 33 + n;
        u32x4 o; o.x = pk2(s[0 * 33] * ks[0], s[1 * 33] * ks[1]); o.y = pk2(s[2 * 33] * ks[2], s[3 * 33] * ks[3]); o.z = pk2(s[4 * 33] * ks[4], s[5 * 33] * ks[5]); o.w = pk2(s[6 * 33] * ks[6], s[7 * 33] * ks[7]);
        *(u32x4*)(dst + (size_t)(drow0 + n0 + n) * dld + k0 + 8 * c) = o; }
    LDS_WAIT(); asm volatile("" ::: "memory");
}
__device__ __forceinline__ void pool_fold_item(const float* w_in, const float* wg, const float* pscale, bf16_t* wt_in, int item, LAS float* scr, int lane) {
    const int g = item >> 6, k0 = (item & 63) * 16;
#pragma unroll
    for (int kk = 0; kk < 16; ++kk) { scr[kk * 128 + lane] = w_in[(size_t)(k0 + kk) * IN_COLS + PU + g * 128 + lane]; scr[kk * 128 + 64 + lane] = w_in[(size_t)(k0 + kk) * IN_COLS + PU + g * 128 + 64 + lane]; }
    LDS_WAIT(); asm volatile("" ::: "memory");
    float a0[16], a1[16];
#pragma unroll
    for (int kk = 0; kk < 16; ++kk) { a0[kk] = 0.f; a1[kk] = 0.f; }
    const float* wgg = wg + (size_t)g * 128 * 128;
    for (int j = 0; j < 128; ++j) { const float w0 = wgg[j * 128 + lane], w1 = wgg[j * 128 + 64 + lane];
#pragma unroll
        for (int kk = 0; kk < 16; ++kk) { const float u = scr[kk * 128 + j]; a0[kk] += u * w0; a1[kk] += u * w1; } }
    const float s0 = pscale[g * 128 + lane], s1 = pscale[g * 128 + 64 + lane];
    u32x4 o;
    bf16_t* d0 = wt_in + (size_t)(PU + g * 128 + lane) * DM + k0; bf16_t* d1 = wt_in + (size_t)(PU + g * 128 + 64 + lane) * DM + k0;
    o.x = pk2(a0[0] * s0, a0[1] * s0); o.y = pk2(a0[2] * s0, a0[3] * s0); o.z = pk2(a0[4] * s0, a0[5] * s0); o.w = pk2(a0[6] * s0, a0[7] * s0); *(u32x4*)d0 = o;
    o.x = pk2(a0[8] * s0, a0[9] * s0); o.y = pk2(a0[10] * s0, a0[11] * s0); o.z = pk2(a0[12] * s0, a0[13] * s0); o.w = pk2(a0[14] * s0, a0[15] * s0); *(u32x4*)(d0 + 8) = o;
    o.x = pk2(a1[0] * s1, a1[1] * s1); o.y = pk2(a1[2] * s1, a1[3] * s1); o.z = pk2(a1[4] * s1, a1[5] * s1); o.w = pk2(a1[6] * s1, a1[7] * s1); *(u32x4*)d1 = o;
    o.x = pk2(a1[8] * s1, a1[9] * s1); o.y = pk2(a1[10] * s1, a1[11] * s1); o.z = pk2(a1[12] * s1, a1[13] * s1); o.w = pk2(a1[14] * s1, a1[15] * s1); *(u32x4*)(d1 + 8) = o;
    LDS_WAIT(); asm volatile("" ::: "memory");
}

constexpr float QSCALE = 0.125f * LOG2E;
__device__ __forceinline__ void prep_weights(const Frame& F, const ArgsV& args, int l) {
    unsigned char* wsw = args.ws + WS_W;
    bf16_t* wt_in = (bf16_t*)(wsw + W_IN);
    LAS float* scr = (LAS float*)(F.lds + F.wave * 8704);
    const int gw = F.vcu * NWAVES + F.wave, NGW = F.G * NWAVES;
    const float* w_in = args.in[2] + (size_t)l * DM * IN_COLS;
    constexpr int I_POOL = 256, I_Q = 256, I_KV = 512, I_ZX = 640, I_G = 1536, I_BR = 768, I_MIX = 512, I_XQ = 128, I_XKV = 256, I_XO = 128, I_EG = 4096, I_EU = 4096, I_ED = 4096;
    constexpr int NITEMS = I_POOL + I_Q + I_KV + I_ZX + I_G + I_BR + I_MIX + I_XQ + I_XKV + I_XO + I_EG + I_EU + I_ED;
    for (int it = gw; it < NITEMS; it += NGW) {
        int r = it;
        if (r < I_POOL) { pool_fold_item(w_in, args.in[10] + (size_t)l * 4 * 128 * 128, args.in[11] + (size_t)l * 512, wt_in, r, scr, F.lane); continue; } r -= I_POOL;
        if (r < I_Q) { tr_item(w_in, IN_COLS, 0, wt_in, DM, 0, (r / 16) * 64, (r % 16) * 32, QSCALE, nullptr, scr, F.lane); continue; } r -= I_Q;
        if (r < I_KV) { tr_item(w_in, IN_COLS, 512, wt_in, DM, 512, (r / 32) * 64, (r % 32) * 32, 1.f, nullptr, scr, F.lane); continue; } r -= I_KV;
        if (r < I_ZX) { tr_item(w_in, IN_COLS, 2048, wt_in, DM, 2048, (r / 40) * 64, (r % 40) * 32, 1.f, nullptr, scr, F.lane); continue; } r -= I_ZX;
        if (r < I_G) { tr_item(w_in, IN_COLS, COL_GATE, wt_in, DM, PG, (r / 96) * 64, (r % 96) * 32, 1.f, nullptr, scr, F.lane); continue; } r -= I_G;
        if (r < I_BR) { const int b = r / 256, q = r % 256;
            tr_item(args.in[18] + (size_t)(l * 3 + b) * 512 * 1024, 1024, 0, (bf16_t*)(wsw + W_BR) + (size_t)b * 1024 * 512, 512, 0, (q / 32) * 64, (q % 32) * 32, 1.f, b == 2 ? args.in[17] + (size_t)l * 512 : nullptr, scr, F.lane); continue; } r -= I_BR;
        if (r < I_MIX) { tr_item(args.in[19] + (size_t)l * 1024 * 1024, 1024, 0, (bf16_t*)(wsw + W_MIX), 1024, 0, (r / 32) * 64, (r % 32) * 32, 1.f, nullptr, scr, F.lane); continue; } r -= I_MIX;
        if (r < I_XQ) { tr_item(args.in[23] + (size_t)l * 1024 * 256, 256, 0, (bf16_t*)(wsw + W_XQ), 1024, 0, (r / 8) * 64, (r % 8) * 32, QSCALE, nullptr, scr, F.lane); continue; } r -= I_XQ;
        if (r < I_XKV) { tr_item(args.in[24] + (size_t)l * 1024 * 512, 512, 0, (bf16_t*)(wsw + W_XKV), 1024, 0, (r / 16) * 64, (r % 16) * 32, 1.f, nullptr, scr, F.lane); continue; } r -= I_XKV;
        if (r < I_XO) { tr_item(args.in[25] + (size_t)l * 256 * 1024, 1024, 0, (bf16_t*)(wsw + W_XO), 256, 0, (r / 32) * 64, (r % 32) * 32, 1.f, nullptr, scr, F.lane); continue; } r -= I_XO;
        if (r < I_EG + I_EU) { const int up = r >= I_EG; if (up) r -= I_EG; const int e = r / 256, q = r % 256, n0 = (q % 16) * 32;
            tr_item(args.in[up ? 32 : 31] + (size_t)(l * 16 + e) * 1024 * 512, 512, 0, (bf16_t*)(wsw + W_GU), 1024, e * 1024 + (n0 / 128) * 256 + (up ? 128 : 0) - (n0 / 128) * 128, (q / 16) * 64, n0, 1.f, nullptr, scr, F.lane); continue; } r -= I_EG + I_EU;
        { const int e = r / 256, q = r % 256;
            tr_item(args.in[33] + (size_t)(l * 16 + e) * 512 * 1024, 1024, 0, (bf16_t*)(wsw + W_DN) + (size_t)e * 1024 * 512, 512, 0, (q / 32) * 64, (q % 32) * 32, 1.f, nullptr, scr, F.lane); }
    }
}

__device__ __forceinline__ void norm_row(const float* xrow, const f32x4 (&gv)[4], bf16_t* orow, int lane, f32x4 (&hv)[4]) {
    const f32x4* xr = (const f32x4*)xrow + lane;
    float s = 0.f;
#pragma unroll
    for (int j = 0; j < 4; ++j) { hv[j] = xr[64 * j]; s += (hv[j].x * hv[j].x + hv[j].y * hv[j].y) + (hv[j].z * hv[j].z + hv[j].w * hv[j].w); }
    const float rstd = 1.0f / sqrtf(wave_sum(s) * (1.f / DM) + EPS);
    unsigned long long* o8 = (unsigned long long*)orow + lane;
#pragma unroll
    for (int j = 0; j < 4; ++j) { hv[j] = hv[j] * rstd * gv[j]; o8[64 * j] = (unsigned long long)pk2(hv[j].x, hv[j].y) | ((unsigned long long)pk2(hv[j].z, hv[j].w) << 32); }
}
__device__ __forceinline__ void load_gain(const float* g, int lane, f32x4 (&gv)[4]) {
#pragma unroll
    for (int j = 0; j < 4; ++j) gv[j] = ((const f32x4*)g + lane)[64 * j];
}
__device__ __forceinline__ void norm_rows_plain(const Frame& F, const float* x, const float* g, bf16_t* H, int nrows) {
    const int gw = F.vcu * NWAVES + F.wave, NGW = F.G * NWAVES;
    f32x4 gv[4], hv[4]; load_gain(g, F.lane, gv);
    for (int m = gw; m < nrows; m += NGW) norm_row(x + (size_t)m * DM, gv, H + (size_t)m * DM, F.lane, hv);
}
__device__ __forceinline__ void norm_rows_dt(const Frame& F, const float* x, const float* g, bf16_t* H, const float* w_in, float* DT) {
    const int gw = F.vcu * NWAVES + F.wave, NGW = F.G * NWAVES;
    f32x4 gv[4], hv[4]; load_gain(g, F.lane, gv);
    f32x4 wd[4][4][2];
#pragma unroll
    for (int j = 0; j < 4; ++j)
#pragma unroll
        for (int i = 0; i < 4; ++i) { const float* p = w_in + (size_t)(4 * F.lane + 256 * j + i) * IN_COLS + COL_DT; wd[j][i][0] = *(const f32x4*)p; wd[j][i][1] = *(const f32x4*)(p + 4); }
    for (int m = gw; m < T; m += NGW) {
        norm_row(x + (size_t)m * DM, gv, H + (size_t)m * DM, F.lane, hv);
        f32x4 d0 = {0.f, 0.f, 0.f, 0.f}, d1 = {0.f, 0.f, 0.f, 0.f};
#pragma unroll
        for (int j = 0; j < 4; ++j)
#pragma unroll
            for (int i = 0; i < 4; ++i) { d0 += wd[j][i][0] * hv[j][i]; d1 += wd[j][i][1] * hv[j][i]; }
#pragma unroll
        for (int q = 0; q < 4; ++q) { d0[q] = wave_sum(d0[q]); d1[q] = wave_sum(d1[q]); }
        if (F.lane == 0) { *(f32x4*)(DT + (size_t)m * 8) = d0; *(f32x4*)(DT + (size_t)m * 8 + 4) = d1; }
    }
}
typedef short v4i16_t __attribute__((ext_vector_type(4)));
__device__ __forceinline__ int crow(int r, int hi) { return (r & 3) + 8 * (r >> 2) + 4 * hi; }
__device__ __forceinline__ s16x4 vtr(const LAS unsigned char* p) { return __builtin_bit_cast(s16x4, __builtin_amdgcn_ds_read_tr16_b64_v4i16((LAS v4i16_t*)p)); }

template <int NMAPS, int DV, bool DIFF>
__device__ __forceinline__ void attn_unit(LAS unsigned char* lds, const int tid_in,
                                          const bf16_t* Qp, const int ldq, const bf16_t* Kp, const bf16_t* Vp, const int ldkv, bf16_t* Op, const int ldo,
                                          const int ntiles, const int q0, const float lam, const float* subg, const float oscale) {
    constexpr int KP = NMAPS * 128 + 16, VP = DV * 2 + 64, KT = 64 * KP, VT = 64 * VP;
    constexpr int KCH = NMAPS * 8, VCH = DV / 8, KN = (64 * KCH) / NTHR, VN = (64 * VCH) / NTHR, NDV = DV / 32;
    constexpr int OFF_K = 0, OFF_V = 2 * KT, OFF_SC = 2 * KT + 2 * VT, OFF_BT = OFF_SC + 8 * 64 * 4, OFF_Q = OFF_BT + 1024;
    constexpr bool QLDS = DIFF;
    static_assert(OFF_Q + (QLDS ? 256 * KP : 0) <= RING_BYTES, "attention LDS");
    int tid = tid_in; asm volatile("" : "+v"(tid));
    const int lane = tid & 63, wave = __builtin_amdgcn_readfirstlane(tid >> 6), r32 = lane & 31, hi = lane >> 5;
    LAS float* sc = (LAS float*)(lds + OFF_SC) + wave * 64;
    const LAS float* btab = (const LAS float*)(lds + OFF_BT);
    bf16x8 qf[QLDS ? 1 : NMAPS][4];
    const LAS unsigned char* qb_ = lds + OFF_Q + (wave * 32 + r32) * KP + hi * 16;
    if constexpr (QLDS) {
#pragma unroll
        for (int i = 0; i < (32 * KCH) / 64; ++i) { const int c_ = lane + i * 64, row_ = c_ / KCH, ch_ = c_ % KCH;
            *(LAS u32x4*)(lds + OFF_Q + (wave * 32 + row_) * KP + ch_ * 16) = *(const u32x4*)(Qp + (size_t)(wave * 32 + row_) * ldq + ch_ * 8); }
    } else {
#pragma unroll
        for (int m = 0; m < NMAPS; ++m)
#pragma unroll
            for (int d0 = 0; d0 < 4; ++d0) qf[m][d0] = *(const bf16x8*)(Qp + (size_t)(wave * 32 + r32) * ldq + m * 64 + d0 * 16 + hi * 8);
    }
    f32x16 O[NMAPS][NDV];
#pragma unroll
    for (int m = 0; m < NMAPS; ++m)
#pragma unroll
        for (int d = 0; d < NDV; ++d)
#pragma unroll
            for (int r = 0; r < 16; ++r) O[m][d][r] = 0.f;
    float mrun[NMAPS], lrun[NMAPS];
#pragma unroll
    for (int m = 0; m < NMAPS; ++m) { mrun[m] = -INFINITY; lrun[m] = 0.f; }
    const int my_last = DIFF ? (q0 + 32 * wave) / 64 : ntiles - 1;
    const int qpos = q0 + 32 * wave + r32;
    u32x4 kreg[KN], vreg[VN];
#define ATT_LOAD(j) do { _Pragma("unroll") for (int i_ = 0; i_ < KN; ++i_) { const int c_ = tid + i_ * NTHR, row_ = c_ / KCH, ch_ = c_ % KCH; kreg[i_] = *(const u32x4*)(Kp + (size_t)((j) * 64 + row_) * ldkv + ch_ * 8); } \
        _Pragma("unroll") for (int i_ = 0; i_ < VN; ++i_) { const int c_ = tid + i_ * NTHR, row_ = c_ / VCH, ch_ = c_ % VCH; vreg[i_] = *(const u32x4*)(Vp + (size_t)((j) * 64 + row_) * ldkv + ch_ * 8); } } while (0)
#define ATT_WRITE(buf) do { _Pragma("unroll") for (int i_ = 0; i_ < KN; ++i_) { const int c_ = tid + i_ * NTHR, row_ = c_ / KCH, ch_ = c_ % KCH; *(LAS u32x4*)(lds + OFF_K + (buf) * KT + row_ * KP + ch_ * 16) = kreg[i_]; } \
        _Pragma("unroll") for (int i_ = 0; i_ < VN; ++i_) { const int c_ = tid + i_ * NTHR, row_ = c_ / VCH, ch_ = c_ % VCH; *(LAS u32x4*)(lds + OFF_V + (buf) * VT + row_ * VP + ch_ * 16) = vreg[i_]; } } while (0)
    ATT_LOAD(0); ATT_WRITE(0);
    __syncthreads();
    for (int j = 0; j < ntiles; ++j) {
        if (j + 1 < ntiles) ATT_LOAD(j + 1);
        if (j <= my_last) {
            const LAS unsigned char* kb = lds + OFF_K + (j & 1) * KT + r32 * KP + hi * 16;
            const LAS unsigned char* vb = lds + OFF_V + (j & 1) * VT + (4 * hi + ((lane & 15) >> 2)) * VP + (16 * ((lane >> 4) & 1) + 4 * (lane & 3)) * 2;
#pragma unroll
            for (int m = 0; m < NMAPS; ++m) {
                __builtin_amdgcn_sched_barrier(0);
                f32x16 s0, s1; bf16x8 pf[4];
#pragma unroll
                for (int r = 0; r < 16; ++r) { s0[r] = 0.f; s1[r] = 0.f; }
#pragma unroll
                for (int d0 = 0; d0 < 4; ++d0) {
                    const bf16x8 k0 = *(const LAS bf16x8*)(kb + m * 128 + d0 * 32);
                    const bf16x8 k1 = *(const LAS bf16x8*)(kb + 32 * KP + m * 128 + d0 * 32);
                    bf16x8 qv; if constexpr (QLDS) qv = *(const LAS bf16x8*)(qb_ + m * 128 + d0 * 32); else qv = qf[m][d0];
                    s0 = __builtin_amdgcn_mfma_f32_32x32x16_bf16(k0, qv, s0, 0, 0, 0);
                    s1 = __builtin_amdgcn_mfma_f32_32x32x16_bf16(k1, qv, s1, 0, 0, 0);
                }
                __builtin_amdgcn_sched_barrier(0);
                if (DIFF) {
                    const int relb = 64 * j + 4 * hi - qpos + 192;
                    if (64 * j + 63 - (q0 + 32 * wave) <= -91) {
                        const float bf = btab[0];
#pragma unroll
                        for (int r = 0; r < 16; ++r) { s0[r] += bf; s1[r] += bf; }
                    } else {
#pragma unroll
                        for (int r = 0; r < 16; ++r) { const int ix = relb + (r & 3) + 8 * (r >> 2); s0[r] += btab[ix]; s1[r] += btab[ix + 32]; }
                    }
                }
                float mx = s0[0];
#pragma unroll
                for (int r = 1; r < 16; ++r) mx = fmaxf(mx, s0[r]);
#pragma unroll
                for (int r = 0; r < 16; ++r) mx = fmaxf(mx, s1[r]);
                mx = fmaxf(mx, __shfl_xor(mx, 32));
                const float mnew = fmaxf(mrun[m], mx);
                const float alpha = __builtin_amdgcn_exp2f(mrun[m] - mnew);
                mrun[m] = mnew;
                float rs = 0.f;
#pragma unroll
                for (int r = 0; r < 16; ++r) { s0[r] = __builtin_amdgcn_exp2f(s0[r] - mnew); s1[r] = __builtin_amdgcn_exp2f(s1[r] - mnew); rs += s0[r] + s1[r]; }
                rs += __shfl_xor(rs, 32);
                lrun[m] = lrun[m] * alpha + rs;
                sc[lane] = alpha;
                float af[16];
#pragma unroll
                for (int r = 0; r < 16; ++r) af[r] = sc[crow(r, hi)];
#pragma unroll
                for (int d = 0; d < NDV; ++d)
#pragma unroll
                    for (int r = 0; r < 16; ++r) O[m][d][r] *= af[r];
                __builtin_amdgcn_sched_barrier(0);
                u32x4 w;
                w.x = pk2(s0[0], s0[1]); w.y = pk2(s0[2], s0[3]); w.z = pk2(s0[4], s0[5]); w.w = pk2(s0[6], s0[7]); pf[0] = __builtin_bit_cast(bf16x8, w);
                w.x = pk2(s0[8], s0[9]); w.y = pk2(s0[10], s0[11]); w.z = pk2(s0[12], s0[13]); w.w = pk2(s0[14], s0[15]); pf[1] = __builtin_bit_cast(bf16x8, w);
                w.x = pk2(s1[0], s1[1]); w.y = pk2(s1[2], s1[3]); w.z = pk2(s1[4], s1[5]); w.w = pk2(s1[6], s1[7]); pf[2] = __builtin_bit_cast(bf16x8, w);
                w.x = pk2(s1[8], s1[9]); w.y = pk2(s1[10], s1[11]); w.z = pk2(s1[12], s1[13]); w.w = pk2(s1[14], s1[15]); pf[3] = __builtin_bit_cast(bf16x8, w);
#pragma unroll
                for (int ks = 0; ks < 4; ++ks)
#pragma unroll
                    for (int d = 0; d < NDV; ++d) {
                        const s16x4 lo = vtr(vb + (16 * ks) * VP + d * 64), hh = vtr(vb + (16 * ks + 8) * VP + d * 64);
                        const bf16x8 vf = (bf16x8){lo[0], lo[1], lo[2], lo[3], hh[0], hh[1], hh[2], hh[3]};
                        O[m][d] = __builtin_amdgcn_mfma_f32_32x32x16_bf16(pf[ks], vf, O[m][d], 0, 0, 0);
                    }
            }
        }
        if (j + 1 < ntiles) ATT_WRITE((j + 1) & 1);
        __syncthreads();
    }
#undef ATT_LOAD
#undef ATT_WRITE
    int lane_e = lane; asm volatile("" : "+v"(lane_e));
    const int r32e = lane_e & 31, hie = lane_e >> 5;
    float a0[16], a1[16];
    sc[lane_e] = 1.0f / lrun[0];
#pragma unroll
    for (int r = 0; r < 16; ++r) a0[r] = sc[crow(r, hie)];
    if (NMAPS == 2) {
        sc[lane_e] = lam / lrun[NMAPS - 1];
#pragma unroll
        for (int r = 0; r < 16; ++r) a1[r] = sc[crow(r, hie)];
    }
#pragma unroll
    for (int d = 0; d < NDV; ++d)
#pragma unroll
        for (int r = 0; r < 16; ++r) O[0][d][r] = (NMAPS == 2) ? (O[0][d][r] * a0[r] - O[NMAPS - 1][d][r] * a1[r]) : O[0][d][r] * a0[r];
#define y O[0]
    if (DIFF) {
        float gg[NDV];
#pragma unroll
        for (int d = 0; d < NDV; ++d) gg[d] = subg[32 * d + r32e] * oscale;
#pragma unroll
        for (int r = 0; r < 16; ++r) {
            float ss = 0.f;
#pragma unroll
            for (int d = 0; d < NDV; ++d) ss += y[d][r] * y[d][r];
            ss += __shfl_xor(ss, 1); ss += __shfl_xor(ss, 2); ss += __shfl_xor(ss, 4); ss += __shfl_xor(ss, 8); ss += __shfl_xor(ss, 16);
            const float rstd = 1.0f / sqrtf(ss * (1.0f / DV) + EPS);
#pragma unroll
            for (int d = 0; d < NDV; ++d) y[d][r] *= rstd * gg[d];
        }
    }
#pragma unroll
    for (int r = 0; r < 16; ++r) {
        bf16_t* orow = Op + (size_t)(wave * 32 + crow(r, hie)) * ldo + r32e;
#pragma unroll
        for (int d = 0; d < NDV; ++d) orow[32 * d] = (bf16_t)f2bf(y[d][r]);
    }
#undef y
    __syncthreads();
}

__device__ __forceinline__ int rel_bucket(int rel) {
    const int n = rel < 0 ? -rel : rel; int b;
    if (n < 8) b = n; else { b = 8 + (n >= 12) + (n >= 16) + (n >= 23) + (n >= 32) + (n >= 46) + (n >= 64) + (n >= 91); }
    return (rel > 0 ? 16 : 0) + b;
}
__device__ __forceinline__ int swz128(int row, int cb) { return row * 128 + (cb ^ (((row >> 1) & 1) << 6)); }
constexpr int SSD_CS = 0, SSD_DTL = 2048;

__device__ __forceinline__ void ssd_dt(const Frame& F, const ArgsV& args, int l, int tb, const float* DT) {
    LAS float* CS = (LAS float*)(F.lds + SSD_CS); LAS float* DTL = (LAS float*)(F.lds + SSD_DTL);
    const int h = F.wave, ll = F.lane;
    const float x = DT[(size_t)(tb + ll) * 8 + h] + args.in[14][l * 8 + h];
    const float dtv = fmaxf(x, 0.f) + log1pf(__expf(-fabsf(x)));
    const float A = -__expf(args.in[15][l * 8 + h]);
    float v = dtv * A;
#pragma unroll
    for (int o = 1; o < 64; o <<= 1) { const float n = __shfl_up(v, o); if (ll >= o) v += n; }
    CS[h * 64 + ll] = v; DTL[h * 64 + ll] = dtv;
}
__device__ __forceinline__ void ssd_conv8(const ArgsV& args, int l, const bf16_t* proj, int tb, int ll, int spos, int col0, float (&o)[8]) {
    const float* cw = args.in[12] + (size_t)l * 4 * 768 + col0; const float* cb = args.in[13] + (size_t)l * 768 + col0;
    { const f32x4 b0 = *(const f32x4*)cb, b1 = *(const f32x4*)(cb + 4); o[0] = b0[0]; o[1] = b0[1]; o[2] = b0[2]; o[3] = b0[3]; o[4] = b1[0]; o[5] = b1[1]; o[6] = b1[2]; o[7] = b1[3]; }
#pragma unroll
    for (int j = 0; j < 4; ++j) {
        if (spos - 3 + j >= 0) {
            const u32x4 xv = *(const u32x4*)(proj + (size_t)(tb + ll - 3 + j) * PC + PX + col0);
            const f32x4 w0 = *(const f32x4*)(cw + j * 768), w1 = *(const f32x4*)(cw + j * 768 + 4);
            o[0] += w0[0] * bf_lo(xv.x); o[1] += w0[1] * bf_hi(xv.x); o[2] += w0[2] * bf_lo(xv.y); o[3] += w0[3] * bf_hi(xv.y);
            o[4] += w1[0] * bf_lo(xv.z); o[5] += w1[1] * bf_hi(xv.z); o[6] += w1[2] * bf_lo(xv.w); o[7] += w1[3] * bf_hi(xv.w);
        }
    }
#pragma unroll
    for (int e = 0; e < 8; ++e) o[e] = siluf_(o[e]);
}
__device__ __forceinline__ u32x4 pack8(const float (&o)[8], float s) { u32x4 w; w.x = pk2(o[0] * s, o[1] * s); w.y = pk2(o[2] * s, o[3] * s); w.z = pk2(o[4] * s, o[5] * s); w.w = pk2(o[6] * s, o[7] * s); return w; }
__device__ __forceinline__ bf16x8 trfrag(const LAS unsigned char* tile, int row, int cb) {
    const s16x4 lo = vtr(tile + swz128(row, cb)), hh = vtr(tile + swz128(row + 4, cb));
    return (bf16x8){lo[0], lo[1], lo[2], lo[3], hh[0], hh[1], hh[2], hh[3]};
}
__device__ __forceinline__ bf16x8 trfrag8(const LAS unsigned char* tile, int row, int cb) {
    const s16x4 lo = vtr(tile + swz128(row, cb)), hh = vtr(tile + swz128(row + 8, cb));
    return (bf16x8){lo[0], lo[1], lo[2], lo[3], hh[0], hh[1], hh[2], hh[3]};
}

__device__ __forceinline__ void ssd_local(const Frame& F, const ArgsV& args, int l, int item) {
    constexpr int OFF_BS = 4096, OFF_XD = 4096 + 2 * 8192;
    const bf16_t* proj = (const bf16_t*)(args.ws + WS_PROJ); const float* DT = (const float*)(args.ws + WS_DT);
    float* STATES = (float*)(args.ws + WS_STATES); float* DEC = (float*)(args.ws + WS_DEC);
    const int b = item >> 5, c = item & 31, tb = b * SEQ + c * 64, lane = F.lane, hi = lane >> 5, r32 = lane & 31;
    const LAS float* CS = (const LAS float*)(F.lds + SSD_CS); const LAS float* DTL = (const LAS float*)(F.lds + SSD_DTL);
    ssd_dt(F, args, l, tb, DT);
    __syncthreads();
    for (int i = 0; i < 10; ++i) {
        const int t_ = F.tid + i * NTHR, ll = t_ / 80, ch = t_ % 80;
        const int col0 = ch < 64 ? ch * 8 : 512 + (ch - 64) * 8;
        float o[8]; ssd_conv8(args, l, proj, tb, ll, c * 64 + ll, col0, o);
        if (ch < 64) { const int h = ch >> 3; const float s = DTL[h * 64 + ll] * __expf(CS[h * 64 + 63] - CS[h * 64 + ll]);
            *(LAS u32x4*)(F.lds + OFF_XD + h * 8192 + swz128(ll, (ch & 7) * 16)) = pack8(o, s); }
        else { const int g = (ch - 64) >> 3; *(LAS u32x4*)(F.lds + OFF_BS + g * 8192 + swz128(ll, ((ch - 64) & 7) * 16)) = pack8(o, 1.f); }
    }
    __syncthreads();
    {
        const int h = F.wave, g = h >> 2;
        const LAS unsigned char* xd = F.lds + OFF_XD + h * 8192; const LAS unsigned char* bs = F.lds + OFF_BS + g * 8192;
        const int q = (lane & 15) >> 2, cbl = (16 * ((lane >> 4) & 1) + 4 * (lane & 3)) * 2;
        f32x16 acc[2][2];
#pragma unroll
        for (int a = 0; a < 2; ++a)
#pragma unroll
            for (int n = 0; n < 2; ++n)
#pragma unroll
                for (int r = 0; r < 16; ++r) acc[a][n][r] = 0.f;
#pragma unroll
        for (int ks = 0; ks < 4; ++ks) {
            bf16x8 af[2], bf[2];
#pragma unroll
            for (int pb = 0; pb < 2; ++pb) { af[pb] = trfrag(xd, 16 * ks + 8 * hi + q, pb * 64 + cbl); bf[pb] = trfrag(bs, 16 * ks + 8 * hi + q, pb * 64 + cbl); }
#pragma unroll
            for (int pb = 0; pb < 2; ++pb)
#pragma unroll
                for (int nb = 0; nb < 2; ++nb) acc[pb][nb] = __builtin_amdgcn_mfma_f32_32x32x16_bf16(af[pb], bf[nb], acc[pb][nb], 0, 0, 0);
        }
        float* st = STATES + (size_t)((b * 32 + c) * 8 + h) * 4096;
#pragma unroll
        for (int pb = 0; pb < 2; ++pb)
#pragma unroll
            for (int nb = 0; nb < 2; ++nb)
#pragma unroll
                for (int r = 0; r < 16; ++r) st[(32 * pb + crow(r, hi)) * 64 + 32 * nb + r32] = acc[pb][nb][r];
        if (lane == 0) DEC[(b * 32 + c) * 8 + h] = __expf(CS[h * 64 + 63]);
    }
    __syncthreads();
}
__device__ __forceinline__ void ssd_scan(const Frame& F, const ArgsV& args) {
    float* STATES = (float*)(args.ws + WS_STATES); const float* DEC = (const float*)(args.ws + WS_DEC);
    for (int gid = F.vcu * NTHR + F.tid; gid < 128 * 1024; gid += F.G * NTHR) {
        const int bh = gid >> 10, e4 = gid & 1023, b = bh >> 3, h = bh & 7;
        f32x4 hreg = {0.f, 0.f, 0.f, 0.f};
#pragma unroll 1
        for (int half = 0; half < 2; ++half) {
            f32x4 s[16]; float d[16];
#pragma unroll
            for (int cc = 0; cc < 16; ++cc) { const int c = half * 16 + cc; s[cc] = *(const f32x4*)(STATES + (size_t)((b * 32 + c) * 8 + h) * 4096 + e4 * 4); d[cc] = DEC[(b * 32 + c) * 8 + h]; }
#pragma unroll
            for (int cc = 0; cc < 16; ++cc) { const int c = half * 16 + cc; *(f32x4*)(STATES + (size_t)((b * 32 + c) * 8 + h) * 4096 + e4 * 4) = hreg; hreg = hreg * d[cc] + s[cc]; }
        }
    }
}
__device__ __forceinline__ void ssd_out(const Frame& F, const ArgsV& args, int l, int item) {
    constexpr int OFF_BS = 4096, OFF_CS = OFF_BS + 2 * 9216, OFF_XS = OFF_CS + 2 * 9216;
    bf16_t* proj = (bf16_t*)(args.ws + WS_PROJ); const float* DT = (const float*)(args.ws + WS_DT);
    const float* STATES = (const float*)(args.ws + WS_STATES); float* SSQ = (float*)(args.ws + WS_SSQ);
    const int b = item >> 5, c = item & 31, tb = b * SEQ + c * 64, lane = F.lane, hi = lane >> 5, r32 = lane & 31;
    const LAS float* CS = (const LAS float*)(F.lds + SSD_CS); const LAS float* DTL = (const LAS float*)(F.lds + SSD_DTL);
    ssd_dt(F, args, l, tb, DT);
    __syncthreads();
    for (int i = 0; i < 12; ++i) {
        const int t_ = F.tid + i * NTHR, ll = t_ / 96, ch = t_ % 96;
        float o[8]; ssd_conv8(args, l, proj, tb, ll, c * 64 + ll, ch * 8, o);
        if (ch < 64) { const int h = ch >> 3; *(LAS u32x4*)(F.lds + OFF_XS + h * 8192 + swz128(ll, (ch & 7) * 16)) = pack8(o, 1.f); }
        else if (ch < 80) { const int g = (ch - 64) >> 3; *(LAS u32x4*)(F.lds + OFF_BS + g * 9216 + ll * 144 + ((ch - 64) & 7) * 16) = pack8(o, 1.f); }
        else { const int g = (ch - 80) >> 3; *(LAS u32x4*)(F.lds + OFF_CS + g * 9216 + ll * 144 + ((ch - 80) & 7) * 16) = pack8(o, 1.f); }
    }
    __syncthreads();
    {
        const int h = F.wave, g = h >> 2;
        const LAS unsigned char* xs = F.lds + OFF_XS + h * 8192; const LAS unsigned char* bs = F.lds + OFF_BS + g * 9216; const LAS unsigned char* cs_t = F.lds + OFF_CS + g * 9216;
        const int q = (lane & 15) >> 2, cbl = (16 * ((lane >> 4) & 1) + 4 * (lane & 3)) * 2;
        const LAS float* csh = CS + h * 64; const LAS float* dth = DTL + h * 64;
        bf16x8 Mf[3][2];
#pragma unroll
        for (int blk = 0; blk < 3; ++blk) {
            const int sb = blk >> 1, lb = (blk + 1) >> 1;
            f32x16 xt;
#pragma unroll
            for (int r = 0; r < 16; ++r) xt[r] = 0.f;
#pragma unroll
            for (int ks = 0; ks < 4; ++ks) {
                const bf16x8 a = *(const LAS bf16x8*)(bs + (32 * sb + r32) * 144 + (16 * ks + 8 * hi) * 2);
                const bf16x8 bq = *(const LAS bf16x8*)(cs_t + (32 * lb + r32) * 144 + (16 * ks + 8 * hi) * 2);
                xt = __builtin_amdgcn_mfma_f32_32x32x16_bf16(a, bq, xt, 0, 0, 0);
            }
            const int lpos = 32 * lb + r32; const float csl = csh[lpos];
#pragma unroll
            for (int r = 0; r < 16; ++r) { const int s = 32 * sb + crow(r, hi); xt[r] = (s <= lpos) ? xt[r] * __expf(csl - csh[s]) * dth[s] : 0.f; }
            u32x4 w;
            w.x = pk2(xt[0], xt[1]); w.y = pk2(xt[2], xt[3]); w.z = pk2(xt[4], xt[5]); w.w = pk2(xt[6], xt[7]); Mf[blk][0] = __builtin_bit_cast(bf16x8, w);
            w.x = pk2(xt[8], xt[9]); w.y = pk2(xt[10], xt[11]); w.z = pk2(xt[12], xt[13]); w.w = pk2(xt[14], xt[15]); Mf[blk][1] = __builtin_bit_cast(bf16x8, w);
        }
        f32x16 acc[2][2];
#pragma unroll
        for (int a = 0; a < 2; ++a)
#pragma unroll
            for (int n = 0; n < 2; ++n)
#pragma unroll
                for (int r = 0; r < 16; ++r) acc[a][n][r] = 0.f;
        const float* hin = STATES + (size_t)((b * 32 + c) * 8 + h) * 4096;
#pragma unroll
        for (int ks = 0; ks < 4; ++ks) {
            bf16x8 cf[2], hf[2];
#pragma unroll
            for (int x = 0; x < 2; ++x) {
                cf[x] = *(const LAS bf16x8*)(cs_t + (32 * x + r32) * 144 + (16 * ks + 8 * hi) * 2);
                const float* hp = hin + (32 * x + r32) * 64 + 16 * ks + 8 * hi; const f32x4 h0 = *(const f32x4*)hp, h1 = *(const f32x4*)(hp + 4);
                u32x4 w; w.x = pk2(h0[0], h0[1]); w.y = pk2(h0[2], h0[3]); w.z = pk2(h1[0], h1[1]); w.w = pk2(h1[2], h1[3]); hf[x] = __builtin_bit_cast(bf16x8, w);
            }
#pragma unroll
            for (int lb = 0; lb < 2; ++lb)
#pragma unroll
                for (int pb = 0; pb < 2; ++pb) acc[lb][pb] = __builtin_amdgcn_mfma_f32_32x32x16_bf16(cf[lb], hf[pb], acc[lb][pb], 0, 0, 0);
        }
#pragma unroll
        for (int lb = 0; lb < 2; ++lb)
#pragma unroll
            for (int r = 0; r < 16; ++r) { const float e = __expf(csh[32 * lb + crow(r, hi)]); acc[lb][0][r] *= e; acc[lb][1][r] *= e; }
#pragma unroll
        for (int blk = 0; blk < 3; ++blk) {
            const int sb = blk >> 1, lb = (blk + 1) >> 1;
#pragma unroll
            for (int s2 = 0; s2 < 2; ++s2)
#pragma unroll
                for (int pb = 0; pb < 2; ++pb) {
                    const bf16x8 xf = trfrag8(xs, 32 * sb + 16 * s2 + 4 * hi + q, pb * 64 + cbl);
                    acc[lb][pb] = __builtin_amdgcn_mfma_f32_32x32x16_bf16(Mf[blk][s2], xf, acc[lb][pb], 0, 0, 0);
                }
        }
        const float Dh = args.in[16][l * 8 + h];
#pragma unroll
        for (int lb = 0; lb < 2; ++lb)
#pragma unroll
            for (int r = 0; r < 16; ++r) {
                const int lpos = 32 * lb + crow(r, hi); const size_t t = (size_t)(tb + lpos);
                float sq = 0.f;
#pragma unroll
                for (int pb = 0; pb < 2; ++pb) {
                    const int p = 32 * pb + r32;
                    const float xv = bf2f(*(const LAS bf16_t*)(xs + swz128(lpos, p * 2)));
                    const float zv = bf2f(proj[t * PC + PZ + h * 64 + p]);
                    const float yz = (acc[lb][pb][r] + Dh * xv) * siluf_(zv);
                    proj[t * PC + PV + h * 64 + p] = (bf16_t)f2bf(yz);
                    sq += yz * yz;
                }
                sq += __shfl_xor(sq, 1); sq += __shfl_xor(sq, 2); sq += __shfl_xor(sq, 4); sq += __shfl_xor(sq, 8); sq += __shfl_xor(sq, 16);
                if (r32 == 0) SSQ[t * 8 + h] = sq;
            }
    }
    __syncthreads();
}
__device__ __forceinline__ void pool_phase(const Frame& F, const ArgsV& args) {
    bf16_t* proj = (bf16_t*)(args.ws + WS_PROJ);
    for (int gid = F.vcu * NTHR + F.tid; gid < T * 64; gid += F.G * NTHR) {
        const int t = gid >> 6, ch = gid & 63, s = t & (SEQ - 1), w = 2 << (ch >> 4);
        const int cnt = (s + 1) < w ? (s + 1) : w;
        float a[8];
#pragma unroll
        for (int e = 0; e < 8; ++e) a[e] = 0.f;
        u32x4 cur = {0u, 0u, 0u, 0u};
        for (int j = 0; j < cnt; ++j) {
            const u32x4 v = *(const u32x4*)(proj + (size_t)(t - j) * PC + PU + ch * 8);
            if (j == 0) cur = v;
            a[0] += bf_lo(v.x); a[1] += bf_hi(v.x); a[2] += bf_lo(v.y); a[3] += bf_hi(v.y); a[4] += bf_lo(v.z); a[5] += bf_hi(v.z); a[6] += bf_lo(v.w); a[7] += bf_hi(v.w);
        }
        const float inv = 1.0f / (float)cnt;
        u32x4 o;
        o.x = pk2(a[0] * inv - bf_lo(cur.x), a[1] * inv - bf_hi(cur.x)); o.y = pk2(a[2] * inv - bf_lo(cur.y), a[3] * inv - bf_hi(cur.y));
        o.z = pk2(a[4] * inv - bf_lo(cur.z), a[5] * inv - bf_hi(cur.z)); o.w = pk2(a[6] * inv - bf_lo(cur.w), a[7] * inv - bf_hi(cur.w));
        *(u32x4*)(proj + (size_t)t * PC + PK + ch * 8) = o;
    }
}
namespace pg8 {
struct BranchProb {
    static constexpr bool GATHER = false;
    const char* A; const char* Bt; unsigned ldb2; int G, c;
    __device__ __forceinline__ bool next(int i, Unit& u) const { const int L = (i / 3) * G + c; if (L >= 512) return false; tile_of(L, 128, 4, u.pm, u.pn); u.x0 = i % 3; u.x1 = 0; return true; }
    __device__ __forceinline__ const char* a_base(const Unit& u, int t) const { return A + (size_t)u.pm * 256 * (PC * 2) + (size_t)u.x0 * 1024 + (size_t)t * 128; }
    __device__ __forceinline__ unsigned a_off(const Unit&, int half, int R, int C) const { return (unsigned)(half * 128 + R) * (unsigned)(PC * 2) + (unsigned)C * 2u; }
    __device__ __forceinline__ const char* b_base(const Unit& u, int t) const { return Bt + (size_t)(u.x0 * 1024 + u.pn * 256) * 1024 + (size_t)t * 128; }
};
struct EpiBranch {
    static constexpr bool PERM = true;
    bf16_t* proj; const float* ssq;
    __device__ __forceinline__ void operator()(const f32x4 (&acc)[2][2][4][2], const Unit& u, int wr, int wc, int fr, int fq) const {
        const int row0 = u.pm * BM + wr * 64 + fr, col0 = u.pn * BM + wc * 32 + 8 * fq, b = u.x0;
#pragma unroll
        for (int ai = 0; ai < 2; ++ai)
#pragma unroll
            for (int m = 0; m < 4; ++m) {
                const size_t row = (size_t)(row0 + ai * HALF + m * 16);
                float rs = 1.f;
                if (b == 2) { const f32x4 q0 = *(const f32x4*)(ssq + row * 8), q1 = *(const f32x4*)(ssq + row * 8 + 4); rs = 1.0f / sqrtf(((q0[0] + q0[1]) + (q0[2] + q0[3]) + (q1[0] + q1[1]) + (q1[2] + q1[3])) * (1.f / 512.f) + EPS); }
#pragma unroll
                for (int bj = 0; bj < 2; ++bj) {
                    const u32x4 gv = *(const u32x4*)(proj + row * PC + PG + b * 1024 + col0 + bj * HALF);
                    bf16_t* mp = proj + row * PC + PU + col0 + bj * HALF;
                    float v[8];
                    v[0] = acc[ai][bj][m][0][0] * rs * bf_lo(gv.x); v[1] = acc[ai][bj][m][0][1] * rs * bf_hi(gv.x); v[2] = acc[ai][bj][m][0][2] * rs * bf_lo(gv.y); v[3] = acc[ai][bj][m][0][3] * rs * bf_hi(gv.y);
                    v[4] = acc[ai][bj][m][1][0] * rs * bf_lo(gv.z); v[5] = acc[ai][bj][m][1][1] * rs * bf_hi(gv.z); v[6] = acc[ai][bj][m][1][2] * rs * bf_lo(gv.w); v[7] = acc[ai][bj][m][1][3] * rs * bf_hi(gv.w);
                    if (b > 0) {
                        const unsigned long long p0 = __hip_atomic_load((const unsigned long long*)mp, __ATOMIC_RELAXED, __HIP_MEMORY_SCOPE_AGENT);
                        const unsigned long long p1 = __hip_atomic_load((const unsigned long long*)mp + 1, __ATOMIC_RELAXED, __HIP_MEMORY_SCOPE_AGENT);
                        const unsigned a0 = (unsigned)p0, a1 = (unsigned)(p0 >> 32), a2 = (unsigned)p1, a3 = (unsigned)(p1 >> 32);
                        v[0] += bf_lo(a0); v[1] += bf_hi(a0); v[2] += bf_lo(a1); v[3] += bf_hi(a1); v[4] += bf_lo(a2); v[5] += bf_hi(a2); v[6] += bf_lo(a3); v[7] += bf_hi(a3);
                    }
                    u32x4 w; w.x = pk2(v[0], v[1]); w.y = pk2(v[2], v[3]); w.z = pk2(v[4], v[5]); w.w = pk2(v[6], v[7]);
                    *(u32x4*)mp = w;
                }
            }
    }
};

struct MoeTab { const volatile LAS int* tb; };
__device__ __forceinline__ void pair_of(int pid, int& lo, int& hi) { lo = pid < 3 ? 0 : (pid < 5 ? 1 : 2); hi = pid < 3 ? pid + 1 : (pid < 5 ? pid - 1 : 3); }
struct MoeGuProb {
    static constexpr bool GATHER = true;
    const char* H; const char* Wgu; const int* list; unsigned ldb2; const volatile LAS int* tb; int G, c;
    __device__ __forceinline__ bool next(int i, Unit& u) const {
        const int L = i * G + c, tile = L >> 3; if (tile >= tb[24]) return false;
        int li = 0;
#pragma unroll 1
        for (int j = 1; j < 24; ++j) li = (tile >= tb[j]) ? j : li;
        u.pm = tile; u.pn = L & 7; u.x0 = li; u.x1 = (tile - tb[li]) * 256; return true;
    }
    __device__ __forceinline__ const char* a_base(const Unit&, int t) const { return H + (size_t)t * 128; }
    __device__ __forceinline__ unsigned a_off(const Unit& u, int half, int R, int C) const {
        const int r = u.x1 + half * 128 + R; const int cnt = tb[32 + u.x0];
        const int tok = r < cnt ? list[(size_t)u.x0 * T + r] : 0;
        return (unsigned)tok * 2048u + (unsigned)C * 2u;
    }
    __device__ __forceinline__ const char* b_base(const Unit& u, int t) const {
        int lo, hi; pair_of(u.x0 % 6, lo, hi); const int e = (u.x0 / 6) * 4 + (u.pn < 4 ? lo : hi);
        return Wgu + (size_t)(e * 1024 + (u.pn & 3) * 256) * 2048 + (size_t)t * 128;
    }
};
struct EpiGateUp {
    static constexpr bool PERM = true;
    bf16_t* amoe; const f32x2* lw;
    __device__ __forceinline__ void operator()(const f32x4 (&acc)[2][2][4][2], const Unit& u, int wr, int wc, int fr, int fq) const {
        const int rl0 = wr * 64 + fr, col0 = u.pn * 128 + wc * 32 + 8 * fq; const int which = u.pn >> 2;
#pragma unroll
        for (int ai = 0; ai < 2; ++ai)
#pragma unroll
            for (int m = 0; m < 4; ++m) {
                const int rl = rl0 + ai * HALF + m * 16;
                const f32x2 wv = lw[(size_t)u.x0 * T + u.x1 + rl]; const float cw = which ? wv.y : wv.x;
                const f32x4 g0 = acc[ai][0][m][0], g1 = acc[ai][0][m][1], u0 = acc[ai][1][m][0], u1 = acc[ai][1][m][1];
                u32x4 w;
                w.x = pk2(siluf_(g0[0]) * u0[0] * cw, siluf_(g0[1]) * u0[1] * cw); w.y = pk2(siluf_(g0[2]) * u0[2] * cw, siluf_(g0[3]) * u0[3] * cw);
                w.z = pk2(siluf_(g1[0]) * u1[0] * cw, siluf_(g1[1]) * u1[1] * cw); w.w = pk2(siluf_(g1[2]) * u1[2] * cw, siluf_(g1[3]) * u1[3] * cw);
                *(u32x4*)(amoe + (size_t)(u.pm * 256 + rl) * 1024 + col0) = w;
            }
    }
};
struct MoeDnProb {
    static constexpr bool GATHER = false;
    const char* A; const char* Wdn; unsigned ldb2; const volatile LAS int* tb; int G, c;
    __device__ __forceinline__ bool next(int i, Unit& u) const {
        const int L = i * G + c, tile = L >> 2; if (tile >= tb[24]) return false;
        int li = 0;
#pragma unroll 1
        for (int j = 1; j < 24; ++j) li = (tile >= tb[j]) ? j : li;
        u.pm = tile; u.pn = L & 3; u.x0 = li; u.x1 = (tile - tb[li]) * 256; return true;
    }
    __device__ __forceinline__ const char* a_base(const Unit& u, int t) const { return A + (size_t)u.pm * 256 * 2048 + (size_t)t * 128; }
    __device__ __forceinline__ unsigned a_off(const Unit&, int half, int R, int C) const { return (unsigned)(half * 128 + R) * 2048u + (unsigned)C * 2u; }
    __device__ __forceinline__ const char* b_base(const Unit& u, int t) const {
        int lo, hi; pair_of(u.x0 % 6, lo, hi); const int e = (u.x0 / 6) * 4 + (t < 8 ? lo : hi);
        return Wdn + (size_t)(e * 1024 + u.pn * 256) * 1024 + (size_t)(t & 7) * 128;
    }
};
struct EpiDown {
    static constexpr bool PERM = false;
    float* x; const int* list; const volatile LAS int* tb;
    __device__ __forceinline__ void operator()(const f32x4 (&acc)[2][2][4][2], const Unit& u, int wr, int wc, int fr, int fq) const {
        const int rl0 = wr * 64 + fr, col0 = u.pn * BM + wc * 32 + 4 * fq; const int cnt = tb[32 + u.x0];
#pragma unroll
        for (int ai = 0; ai < 2; ++ai)
#pragma unroll
            for (int m = 0; m < 4; ++m) {
                const int r = u.x1 + rl0 + ai * HALF + m * 16;
                if (r < cnt) {
                    const int tok = list[(size_t)u.x0 * T + r]; float* xp = x + (size_t)tok * DM + col0;
#pragma unroll
                    for (int bj = 0; bj < 2; ++bj)
#pragma unroll
                        for (int n = 0; n < 2; ++n) { const f32x4 bs = *(const f32x4*)(xp + bj * HALF + n * 16); *(f32x4*)(xp + bj * HALF + n * 16) = bs + acc[ai][bj][m][n]; }
                }
            }
    }
};
}

__device__ __forceinline__ void moe_route(const Frame& F, const ArgsV& args, int l) {
    constexpr int OFF_W = 0, OFF_CNT = 81920, OFF_BASE = 82048, OFF_REC = 82176;
    LAS float* W = (LAS float*)(F.lds + OFF_W); volatile LAS int* lcnt = (volatile LAS int*)(F.lds + OFF_CNT); volatile LAS int* lbase = (volatile LAS int*)(F.lds + OFF_BASE);
    LAS int* rec = (LAS int*)(F.lds + OFF_REC);
    const float* wrg = args.in[27] + (size_t)l * DM * 4; const float* wre = args.in[29] + (size_t)l * DM * 16;
    const float* brg = args.in[28] + l * 4; const float* bre = args.in[30] + l * 16;
    float* x = args.out; bf16_t* H = (bf16_t*)(args.ws + WS_H);
    int* list = (int*)(args.ws + WS_LIST); f32x2* lw = (f32x2*)(args.ws + WS_LW);
    unsigned* gcnt = (unsigned*)(args.ws + WS_CTL) + CW_CNT + l * 32;
    for (int i = F.tid; i < DM * 4; i += NTHR) W[(i & 3) * DM + (i >> 2)] = wrg[i];
    for (int i = F.tid; i < DM * 16; i += NTHR) W[(4 + (i & 15)) * DM + (i >> 4)] = wre[i];
    f32x4 gv[4], hv[4]; load_gain(args.in[26] + (size_t)l * DM, F.lane, gv);
    const int rows_per_wg = T / F.G;
    for (int base = 0; base < rows_per_wg; base += 128) {
        if (F.tid < 24) lcnt[F.tid] = 0;
        __syncthreads();
        const int nrow = (rows_per_wg - base) < 128 ? (rows_per_wg - base) : 128;
        for (int rr = F.wave; rr < nrow; rr += NWAVES) {
            const int m = F.vcu * rows_per_wg + base + rr;
            norm_row(x + (size_t)m * DM, gv, H + (size_t)m * DM, F.lane, hv);
            float lg[20];
#pragma unroll
            for (int cidx = 0; cidx < 20; ++cidx) {
                float s = 0.f;
#pragma unroll
                for (int j = 0; j < 4; ++j) { const f32x4 wv = *(const LAS f32x4*)(W + cidx * DM + 4 * F.lane + 256 * j); s += (hv[j].x * wv.x + hv[j].y * wv.y) + (hv[j].z * wv.z + hv[j].w * wv.w); }
                lg[cidx] = wave_sum(s);
            }
            if (F.lane == 0) {
                float gl[4]; float gm = -INFINITY; int gi = 0;
#pragma unroll
                for (int j = 0; j < 4; ++j) { gl[j] = lg[j] + brg[j]; if (gl[j] > gm) { gm = gl[j]; gi = j; } }
                float gs = 0.f;
#pragma unroll
                for (int j = 0; j < 4; ++j) gs += __expf(gl[j] - gm);
                const float g_p = 1.0f / gs;
                float el[4];
#pragma unroll
                for (int j = 0; j < 4; ++j) { float v = 0.f;
#pragma unroll
                    for (int q = 0; q < 4; ++q) v = (gi == q) ? lg[4 + q * 4 + j] + bre[q * 4 + j] : v;
                    el[j] = v; }
                int e0 = 0; float v0 = el[0];
#pragma unroll
                for (int j = 1; j < 4; ++j) if (el[j] > v0) { v0 = el[j]; e0 = j; }
                int e1 = -1; float v1 = -INFINITY;
#pragma unroll
                for (int j = 0; j < 4; ++j) if (j != e0 && el[j] > v1) { v1 = el[j]; e1 = j; }
                const float w1 = __expf(v1 - v0), inv = 1.0f / (1.0f + w1);
                const float c0 = g_p * inv, c1 = g_p * w1 * inv;
                const int lo = e0 < e1 ? e0 : e1, hi = e0 < e1 ? e1 : e0;
                const int pid = lo == 0 ? hi - 1 : (lo == 1 ? hi + 1 : 5);
                const int li = gi * 6 + pid;
                const int slot = __hip_atomic_fetch_add((LAS int*)&lcnt[li], 1, __ATOMIC_RELAXED, __HIP_MEMORY_SCOPE_WORKGROUP);
                rec[rr * 4 + 0] = li; rec[rr * 4 + 1] = slot; rec[rr * 4 + 2] = __float_as_int(e0 < e1 ? c0 : c1); rec[rr * 4 + 3] = __float_as_int(e0 < e1 ? c1 : c0);
            }
        }
        __syncthreads();
        if (F.tid < 24) { const int n = lcnt[F.tid]; lbase[F.tid] = n ? (int)atomicAdd(&gcnt[F.tid], (unsigned)n) : 0; }
        __syncthreads();
        if (F.tid < nrow) {
            const int li = rec[F.tid * 4 + 0], slot = lbase[li] + rec[F.tid * 4 + 1];
            const int m = F.vcu * rows_per_wg + base + F.tid;
            list[(size_t)li * T + slot] = m;
            lw[(size_t)li * T + slot] = (f32x2){__int_as_float(rec[F.tid * 4 + 2]), __int_as_float(rec[F.tid * 4 + 3])};
        }
        __syncthreads();
    }
}
__device__ __forceinline__ void moe_table(const Frame& F, const ArgsV& args, int l, volatile LAS int* tb) {
    const unsigned* gcnt = (const unsigned*)(args.ws + WS_CTL) + CW_CNT + l * 32;
    if (F.tid < 24) tb[32 + F.tid] = (int)__hip_atomic_load(gcnt + F.tid, __ATOMIC_RELAXED, __HIP_MEMORY_SCOPE_AGENT);
    __syncthreads();
    if (F.tid == 0) { int acc = 0; for (int j = 0; j < 24; ++j) { tb[j] = acc; acc += (tb[32 + j] + 255) >> 8; } tb[24] = acc; }
    __syncthreads();
}
__device__ __forceinline__ void final_norm_row(const float* xrow, float* orow, const float* g, int lane) {
    const f32x4* xr = (const f32x4*)xrow + lane; const f32x4* gr = (const f32x4*)g + lane;
    f32x4 v[4]; float s = 0.f;
#pragma unroll
    for (int j = 0; j < 4; ++j) { v[j] = xr[64 * j]; s += (v[j].x * v[j].x + v[j].y * v[j].y) + (v[j].z * v[j].z + v[j].w * v[j].w); }
    const float rstd = 1.0f / sqrtf(wave_sum(s) * (1.f / DM) + EPS);
#pragma unroll
    for (int j = 0; j < 4; ++j) { const f32x4 gg = gr[64 * j]; ((f32x4*)orow + lane)[64 * j] = v[j] * rstd * gg; }
}

constexpr int NPH = 14;
constexpr int NSTEPS = DEPTH * NPH + 1;
#ifndef EN_MIX
#define EN_MIX 1
#endif
#ifndef EN_XATTN
#define EN_XATTN 1
#endif
#ifndef EN_MOE
#define EN_MOE 1
#endif

__device__ __forceinline__ int launder(int v) { asm volatile("" : "+s"(v)); return v; }
__device__ __forceinline__ unsigned char* launder_p(unsigned char* p) { asm volatile("" : "+s"(p)); return p; }

__device__ __forceinline__ const AS4 unsigned char* launder_ka(const AS4 unsigned char* p) { asm volatile("" : "+s"(p)); return p; }

__global__ void __launch_bounds__(NTHR, 2) mega(Args kargs) {
    extern __shared__ __attribute__((aligned(16))) unsigned char lds_raw[];
    Frame F0;
    F0.lds = (LAS unsigned char*)lds_raw;
    F0.tid = threadIdx.x; F0.lane = F0.tid & 63; F0.wave = __builtin_amdgcn_readfirstlane(F0.tid >> 6);
    F0.G = gridDim.x; { const int bx = blockIdx.x; F0.vcu = (F0.G % 8 == 0) ? (bx % 8) * (F0.G / 8) + bx / 8 : bx; }
    volatile LAS unsigned* MISC = (volatile LAS unsigned*)(F0.lds + MISC_OFF);
    for (int u = F0.tid; u < (LDS_BYTES - MISC_OFF) / 4; u += NTHR) MISC[u] = 0u;
    __syncthreads();
    const int s_lo = kargs.s_lo, s_hi = kargs.s_hi;
    const bool use_bar = (s_hi - s_lo) > 1;
    XcdBarrier bar; bar.bar = (unsigned*)(kargs.ws + WS_CTL) + CW_BAR; bar.x = 0; bar.st = nullptr;
    if (use_bar) bar = xcd_barrier_post((unsigned*)(kargs.ws + WS_CTL) + CW_BAR, MISC + 8);
#ifndef ONLY_STEP
#define ONLY_STEP -1
#endif
#ifndef SKIP_STEP
#define SKIP_STEP -2
#endif
#ifndef STEP_MASK
#define STEP_MASK 0xffff
#endif
#define STEP_ON(p) ((ONLY_STEP < 0 || ONLY_STEP == (p)) && SKIP_STEP != (p) && ((STEP_MASK >> (p)) & 1))
#define IN(s) (launder(s_lo) <= (s) && (s) < launder(s_hi) && STEP_ON(((s) % NPH)))
#define SEAM(s) do { if (IN(s) && IN((s) + 1)) xcd_barrier(bar); } while (0)
#define PHASE_VARS Frame F = F0; F.wave = launder(F0.wave); F.lane = (int)__builtin_amdgcn_mbcnt_hi(~0u, __builtin_amdgcn_mbcnt_lo(~0u, 0u)); asm volatile("" : "+v"(F.lane)); F.tid = F.wave * 64 + F.lane; F.vcu = launder(F0.vcu); F.G = launder(F0.G); const int bid = launder((int)blockIdx.x); (void)bid; \
    const int l = launder(lraw); ArgsV args; args.in.ka = launder_ka((const AS4 unsigned char*)__builtin_amdgcn_kernarg_segment_ptr()); args.out = *(float* const AS4*)(args.in.ka + 280); args.ws = *(unsigned char* const AS4*)(args.in.ka + 288); unsigned char* ws = args.ws; unsigned char* wsw = ws + WS_W; float* out = args.out; \
    bf16_t* H = (bf16_t*)(ws + WS_H); bf16_t* MEMN = (bf16_t*)(ws + WS_MEMN); bf16_t* PROJ = (bf16_t*)(ws + WS_PROJ); \
    const float* xin = (l == 0) ? args.in[0] : out; (void)wsw; (void)H; (void)MEMN; (void)PROJ; (void)xin; (void)out

    for (int lraw = 0; lraw < DEPTH; ++lraw) {
        const int sb = lraw * NPH;
        if (IN(sb + 0)) {
            PHASE_VARS;
            const int gw = F.vcu * NWAVES + F.wave, NGW = F.G * NWAVES;
            prep_weights(F, args, l);
            if (l == 0 && !EN_MIX) {
                for (int m = gw; m < T; m += NGW) { const f32x4* s = (const f32x4*)(args.in[0] + (size_t)m * DM) + F.lane; f32x4* d = (f32x4*)(out + (size_t)m * DM) + F.lane;
#pragma unroll
                    for (int j = 0; j < 4; ++j) d[64 * j] = s[64 * j]; }
            }
            if (EN_MIX) norm_rows_dt(F, xin, args.in[20] + (size_t)l * DM, H, args.in[2] + (size_t)l * DM * IN_COLS, (float*)(ws + WS_DT));
            if (EN_XATTN) norm_rows_plain(F, args.in[1], args.in[22] + (size_t)l * DM, MEMN, BATCH * NMEM);
        }
        SEAM(sb + 0);
        if (IN(sb + 1)) {
            PHASE_VARS;
            if (EN_MIX) {
                pg8::PlainProb P{(const char*)H, (const char*)(wsw + W_IN), 2048u, 2048u, 128, 25, F.G, bid};
                pg8::EpiStore E{PROJ, PC, 13, args.in[3] + (size_t)l * 3072, PG};
                pg8::gemm_phase<pg8::EpiStore, pg8::PlainProb, true>(F.lds, F.tid, P, E, 16);
            }
            if (EN_XATTN) {
                pg8::PlainProb P{(const char*)MEMN, (const char*)(wsw + W_XKV), 2048u, 2048u, 16, 2, F.G, bid};
                pg8::EpiStore E{(bf16_t*)(ws + WS_KV), 512, 1 << 30, nullptr, 0};
                pg8::gemm_phase<pg8::EpiStore, pg8::PlainProb, true>(F.lds, F.tid, P, E, 16);
            }
        }
        SEAM(sb + 1);
        if (IN(sb + 2) && EN_MIX) { PHASE_VARS; for (int it = F.vcu; it < 512; it += F.G) ssd_local(F, args, l, it); }
        SEAM(sb + 2);
        if (IN(sb + 3) && EN_MIX) {
            PHASE_VARS;
            ssd_scan(F, args);
            const float lam_init = 0.8f - 0.6f * __expf(-0.3f * (float)l);
            float lam;
            { float s1 = 0.f, s2 = 0.f; for (int i = 0; i < 64; ++i) { s1 += args.in[4][l * 64 + i] * args.in[5][l * 64 + i]; s2 += args.in[6][l * 64 + i] * args.in[7][l * 64 + i]; }
              lam = __expf(s1) - __expf(s2) + lam_init; }
            for (int it = F.vcu; it < 256; it += F.G) {
                const int bh = it >> 2, b = bh >> 2, h = bh & 3, sidx = it & 3;
                LAS float* btab = (LAS float*)(F.lds + 2 * 64 * 272 + 2 * 64 * 320 + 8 * 64 * 4);
                if (F.tid < 256) btab[F.tid] = args.in[9][rel_bucket(F.tid - 192) * 4 + h] * LOG2E;
                __syncthreads();
                for (int k = 0; k < 2; ++k) {
                    const int qb = k ? 7 - sidx : sidx, q0 = qb * 256;
                    const bf16_t* base = PROJ + (size_t)(b * SEQ) * PC;
                    attn_unit<2, 128, true>(F.lds, F.tid, base + (size_t)q0 * PC + PQ + h * 128, PC, base + PK + h * 128, base + PV + h * 128, PC,
                                            PROJ + (size_t)(b * SEQ + q0) * PC + PQ + h * 128, PC, q0 / 64 + 4, q0, lam, args.in[8] + (size_t)l * 128, 1.0f - lam_init);
                }
            }
        }
        SEAM(sb + 3);
        if (IN(sb + 4) && EN_MIX) {
            PHASE_VARS;
            for (int it = F.vcu; it < 512; it += F.G) ssd_out(F, args, l, it);
            pool_phase(F, args);
        }
        SEAM(sb + 4);
        if (IN(sb + 5) && EN_MIX) {
            PHASE_VARS;
            pg8::BranchProb P{(const char*)PROJ, (const char*)(wsw + W_BR), 1024u, F.G, bid};
            pg8::EpiBranch E{PROJ, (const float*)(ws + WS_SSQ)};
            pg8::gemm_phase<pg8::EpiBranch, pg8::BranchProb, true>(F.lds, F.tid, P, E, 8);
        }
        SEAM(sb + 5);
        if (IN(sb + 6) && EN_MIX) {
            PHASE_VARS;
            pg8::PlainProb P{(const char*)(PROJ + PU), (const char*)(wsw + W_MIX), (unsigned)(PC * 2), 2048u, 128, 4, F.G, bid};
            pg8::EpiResid E{xin, out, DM};
            pg8::gemm_phase<pg8::EpiResid, pg8::PlainProb, true>(F.lds, F.tid, P, E, 16);
        }
        SEAM(sb + 6);
        if (IN(sb + 7) && EN_XATTN) { PHASE_VARS; norm_rows_plain(F, out, args.in[21] + (size_t)l * DM, H, T); }
        SEAM(sb + 7);
        if (IN(sb + 8) && EN_XATTN) {
            PHASE_VARS;
            pg8::PlainProb P{(const char*)H, (const char*)(wsw + W_XQ), 2048u, 2048u, 128, 1, F.G, bid};
            pg8::EpiStore E{(bf16_t*)(ws + WS_XQ), 256, 1 << 30, nullptr, 0};
            pg8::gemm_phase<pg8::EpiStore, pg8::PlainProb, true>(F.lds, F.tid, P, E, 16);
        }
        SEAM(sb + 8);
        if (IN(sb + 9) && EN_XATTN) {
            PHASE_VARS;
            for (int it = F.vcu; it < 512; it += F.G) {
                const int b = it >> 5, h = (it >> 3) & 3, qb = it & 7;
                const bf16_t* XQ = (const bf16_t*)(ws + WS_XQ); bf16_t* XO = (bf16_t*)(ws + WS_XO); const bf16_t* KV = (const bf16_t*)(ws + WS_KV);
                attn_unit<1, 64, false>(F.lds, F.tid, XQ + (size_t)(b * SEQ + qb * 256) * 256 + h * 64, 256, KV + (size_t)(b * NMEM) * 512 + h * 64, KV + (size_t)(b * NMEM) * 512 + 256 + h * 64, 512,
                                        XO + (size_t)(b * SEQ + qb * 256) * 256 + h * 64, 256, 4, 0, 0.f, nullptr, 1.f);
            }
        }
        SEAM(sb + 9);
        if (IN(sb + 10) && EN_XATTN) {
            PHASE_VARS;
            pg8::PlainProb P{(const char*)(ws + WS_XO), (const char*)(wsw + W_XO), 512u, 512u, 128, 4, F.G, bid};
            pg8::EpiResid E{out, out, DM};
            pg8::gemm_phase<pg8::EpiResid, pg8::PlainProb, true>(F.lds, F.tid, P, E, 4);
        }
        SEAM(sb + 10);
        if (IN(sb + 11) && EN_MOE) { PHASE_VARS; moe_route(F, args, l); }
        SEAM(sb + 11);
        if (IN(sb + 12) && EN_MOE) {
            PHASE_VARS;
            volatile LAS int* mtab = (volatile LAS int*)(F.lds + MISC_OFF + 256);
            moe_table(F, args, l, mtab);
            pg8::MoeGuProb P{(const char*)H, (const char*)(wsw + W_GU), (const int*)(ws + WS_LIST), 2048u, mtab, F.G, bid};
            pg8::EpiGateUp E{(bf16_t*)(ws + WS_AMOE), (const f32x2*)(ws + WS_LW)};
            pg8::gemm_phase<pg8::EpiGateUp, pg8::MoeGuProb, true>(F.lds, F.tid, P, E, 16);
        }
        SEAM(sb + 12);
        if (IN(sb + 13) && EN_MOE) {
            PHASE_VARS;
            volatile LAS int* mtab = (volatile LAS int*)(F.lds + MISC_OFF + 256);
            moe_table(F, args, l, mtab);
            pg8::MoeDnProb P{(const char*)(ws + WS_AMOE), (const char*)(wsw + W_DN), 1024u, mtab, F.G, bid};
            pg8::EpiDown E{out, (const int*)(ws + WS_LIST), mtab};
            pg8::gemm_phase<pg8::EpiDown, pg8::MoeDnProb, true>(F.lds, F.tid, P, E, 16);
        }
        SEAM(sb + 13);
    }
    if (IN(DEPTH * NPH)) {
        const int gw = F0.vcu * NWAVES + F0.wave, NGW = F0.G * NWAVES; float* out = kargs.out;
        const int lane_f = (int)__builtin_amdgcn_mbcnt_hi(~0u, __builtin_amdgcn_mbcnt_lo(~0u, 0u));
        for (int m = gw; m < T; m += NGW) final_norm_row(out + (size_t)m * DM, out + (size_t)m * DM, kargs.in[34], lane_f);
    }
#undef IN
#undef SEAM
}

extern "C" void kernel_launch(void* const* d_in, const int* in_sizes, int n_in, void* d_out, int out_size, void* d_ws, size_t ws_size, hipStream_t stream) {
    static int grid = 0;
    if (grid == 0) {
        if (n_in != 35 || out_size != T * DM || ws_size < WS_END) { fprintf(stderr, "kernel_launch: unexpected sizes n_in %d out %d ws %zu (need %zu)\n", n_in, out_size, ws_size, (size_t)WS_END); grid = -1; return; }
        int dev = 0, cus = 0, per_cu = 0;
        if (hipGetDevice(&dev) != hipSuccess || hipDeviceGetAttribute(&cus, hipDeviceAttributeMultiprocessorCount, dev) != hipSuccess) { grid = -1; return; }
        if (hipFuncSetAttribute((const void*)mega, hipFuncAttributeMaxDynamicSharedMemorySize, LDS_BYTES) != hipSuccess) { fprintf(stderr, "kernel_launch: hipFuncSetAttribute failed\n"); grid = -1; return; }
        if (hipOccupancyMaxActiveBlocksPerMultiprocessor(&per_cu, (const void*)mega, NTHR, LDS_BYTES) != hipSuccess || per_cu < 1) fprintf(stderr, "kernel_launch: occupancy query says %d\n", per_cu);
        (void)hipGetLastError();
        if (cus < 256) { fprintf(stderr, "kernel_launch: built for a 256-CU device, found %d CUs\n", cus); grid = -1; return; }
        grid = 256;
    }
    if (grid < 0) return;
    (void)hipMemsetAsync((char*)d_ws + WS_CTL, 0, CTL_BYTES, stream);
    Args a; memset(&a, 0, sizeof(a));
    for (int i = 0; i < 35; ++i) a.in[i] = (const float*)d_in[i];
    a.out = (float*)d_out; a.ws = (unsigned char*)d_ws;
#ifndef ONE_LAUNCH
#define ONE_LAUNCH 1
#endif
#if ONE_LAUNCH
    a.s_lo = 0; a.s_hi = NSTEPS;
    hipLaunchKernelGGL(mega, dim3(grid), dim3(NTHR), LDS_BYTES, stream, a);
#else
    for (int s = 0; s < NSTEPS; ++s) { a.s_lo = s; a.s_hi = s + 1; hipLaunchKernelGGL(mega, dim3(grid), dim3(NTHR), LDS_BYTES, stream, a); }
#endif
}
```

```cpp
#define NT_STORES 1
#include <hip/hip_runtime.h>
#include <cstdio>
#include <cstdint>
#include <cstring>

#define LAS __attribute__((address_space(3)))
#define GAS __attribute__((address_space(1)))
typedef unsigned short bf16_t;
typedef short bf16x8 __attribute__((ext_vector_type(8)));
typedef short s16x4 __attribute__((ext_vector_type(4)));
typedef float f32x2 __attribute__((ext_vector_type(2)));
typedef float f32x4 __attribute__((ext_vector_type(4)));
typedef float f32x16 __attribute__((ext_vector_type(16)));
typedef unsigned u32x2 __attribute__((ext_vector_type(2)));
typedef unsigned u32x4 __attribute__((ext_vector_type(4)));

constexpr int DM = 1024, BATCH = 16, SEQ = 2048, T = BATCH * SEQ, DEPTH = 4, NMEM = 256;
constexpr int IN_COLS = 6408, COL_DT = 3328, COL_GATE = 3336;
constexpr int PC = 6400;
constexpr int PQ = 0, PK = 512, PV = 1024, PU = 1536, PZ = 2048, PX = 2560, PG = 3328;
constexpr float EPS = 1e-6f;
constexpr float LOG2E = 1.4426950408889634f;
constexpr int NWAVES = 8, NTHR = 512;

constexpr size_t MiB = 1u << 20;
constexpr size_t WS_CTL = 0, CTL_BYTES = 1 * MiB;
constexpr size_t WS_W = 1 * MiB;
constexpr size_t W_IN = 0;
constexpr size_t W_XKV = W_IN + (size_t)6400 * 1024 * 2;
constexpr size_t W_BR = W_XKV + (size_t)512 * 1024 * 2;
constexpr size_t W_MIX = W_BR + (size_t)3 * 1024 * 512 * 2;
constexpr size_t W_XQ = W_MIX + (size_t)1024 * 1024 * 2;
constexpr size_t W_XO = W_XQ + (size_t)256 * 1024 * 2;
constexpr size_t W_GU = W_XO + (size_t)1024 * 256 * 2;
constexpr size_t W_DN = W_GU + (size_t)16 * 1024 * 1024 * 2;
constexpr size_t W_END = W_DN + (size_t)16 * 1024 * 512 * 2;
constexpr size_t WS_H = WS_W + 68 * MiB;
constexpr size_t WS_MEMN = WS_H + (size_t)T * DM * 2;
constexpr size_t WS_PROJ = WS_MEMN + (size_t)4096 * DM * 2;
constexpr size_t WS_STATES = WS_PROJ + (size_t)T * PC * 2;
constexpr size_t WS_DT = WS_STATES + (size_t)64 * MiB;
constexpr size_t WS_SSQ = WS_DT + 1 * MiB;
constexpr size_t WS_DEC = WS_SSQ + 1 * MiB;
constexpr size_t WS_KV = WS_DEC + 1 * MiB;
constexpr size_t WS_LIST = WS_KV + 4 * MiB;
constexpr size_t WS_LW = WS_LIST + (size_t)24 * T * 4;
constexpr size_t WS_END = WS_LW + (size_t)24 * T * 8;
static_assert(W_END <= 68 * MiB, "weights region");
constexpr size_t WS_XQ = WS_PROJ;
constexpr size_t WS_XO = WS_PROJ + 16 * MiB;
constexpr size_t WS_AMOE = WS_PROJ;

constexpr int CW_BAR = 1024;
constexpr int CW_CNT = 8192;

constexpr int RING_BYTES = 155648;
constexpr int MISC_OFF = RING_BYTES;
constexpr int LDS_BYTES = 163840;

__device__ __forceinline__ unsigned f2bf(float f) { unsigned u = __builtin_bit_cast(unsigned, f); return (u + 0x7fffu + ((u >> 16) & 1u)) >> 16; }
__device__ __forceinline__ unsigned pk2(float lo, float hi) { typedef __bf16 bf2 __attribute__((ext_vector_type(2))); f32x2 v = {lo, hi}; bf2 b = __builtin_convertvector(v, bf2); return __builtin_bit_cast(unsigned, b); }
__device__ __forceinline__ float bf_lo(unsigned w) { return __builtin_bit_cast(float, w << 16); }
__device__ __forceinline__ float bf_hi(unsigned w) { return __builtin_bit_cast(float, w & 0xffff0000u); }
__device__ __forceinline__ float bf2f(bf16_t b) { return __builtin_bit_cast(float, ((unsigned)b) << 16); }
__device__ __forceinline__ float wave_sum(float v) {
#pragma unroll
    for (int o = 1; o < 64; o <<= 1) v += __shfl_xor(v, o);
    return v;
}
__device__ __forceinline__ float sigmoidf_(float x) { return __builtin_amdgcn_rcpf(1.0f + __builtin_amdgcn_exp2f(x * -1.4426950408889634f)); }
__device__ __forceinline__ float siluf_(float x) { return x * __builtin_amdgcn_rcpf(1.0f + __builtin_amdgcn_exp2f(x * -1.4426950408889634f)); }
__device__ __forceinline__ float zero_v() { float z = 0.f; asm volatile("" : "+v"(z)); return z; }
#define LDS_WAIT() asm volatile("s_waitcnt lgkmcnt(0)" ::: "memory")
#define VM_WAIT() asm volatile("s_waitcnt vmcnt(0)" ::: "memory")

#define XB_TMO      128
#define XB_XCNT(j)  (256  + 64 * (j))
#define XB_XSUB(j)  (1280 + 64 * (j))
#define XB_XGEN(j)  (2304 + 64 * (j))
#define XB_TOP      3328
#define XB_TOPGEN   3392
#define XCD_BAR_WORDS 3456
#define XB_SPIN_CAP (1u << 18)
__device__ __forceinline__ unsigned xb_ld(unsigned* p)              { return __hip_atomic_load(p, __ATOMIC_RELAXED, __HIP_MEMORY_SCOPE_AGENT); }
__device__ __forceinline__ unsigned xb_add(unsigned* p, unsigned v) { return __hip_atomic_fetch_add(p, v, __ATOMIC_RELAXED, __HIP_MEMORY_SCOPE_AGENT); }
__device__ __forceinline__ unsigned xb_xcc_id() { return (unsigned)__builtin_amdgcn_s_getreg((3 << 11) | 20) & 0xFu; }
#define XB_SPIN(cond, bar) do { unsigned _sp = 0; while (cond) { __builtin_amdgcn_s_sleep(1); \
    if ((++_sp & 255u) == 0u) { if (xb_ld(&(bar)[XB_TMO])) break; if (_sp > XB_SPIN_CAP) { atomicAdd(&(bar)[XB_TMO], 1u); break; } } } } while (0)
struct XcdBarrier { unsigned* bar; unsigned x; volatile LAS unsigned* st; };
__device__ __forceinline__ XcdBarrier xcd_barrier_post(unsigned* bar, volatile LAS unsigned* st) {
    XcdBarrier b; b.bar = bar; b.x = xb_xcc_id(); b.st = st;
    if (threadIdx.x == 0) (void)xb_add(&bar[XB_XCNT(b.x)], 1u);
    return b;
}
__device__ __forceinline__ void xcd_barrier_complete(unsigned* bar, unsigned x, unsigned& nloc, unsigned& nx) {
    const unsigned G = gridDim.x * gridDim.y * gridDim.z;
    unsigned sum, cnt, mine, sp = 0u;
    for (;;) {
        sum = 0u; cnt = 0u; mine = 0u;
#pragma unroll
        for (unsigned j = 0; j < 16; ++j) { const unsigned c = xb_ld(&bar[XB_XCNT(j)]); sum += c; cnt += (c > 0u) ? 1u : 0u; mine = (j == x) ? c : mine; }
        if (sum == G) break;
        __builtin_amdgcn_s_sleep(1);
        if ((++sp & 255u) == 0u) { if (xb_ld(&bar[XB_TMO])) break; if (sp > XB_SPIN_CAP) { atomicAdd(&bar[XB_TMO], 1u); break; } }
    }
    nloc = mine > 0u ? mine : 1u; nx = cnt > 0u ? cnt : 1u;
}
__device__ __forceinline__ void xcd_barrier(const XcdBarrier& b) {
    asm volatile("s_waitcnt vmcnt(0)" ::: "memory");
    __syncthreads();
    if (threadIdx.x == 0) {
        unsigned* bar = b.bar; asm volatile("" : "+s"(bar));
        __builtin_amdgcn_s_waitcnt(0);
        unsigned nloc = b.st[0], nx = b.st[1];
        if (nloc == 0u) { xcd_barrier_complete(bar, b.x, nloc, nx); b.st[0] = nloc; b.st[1] = nx; }
        const unsigned old = xb_add(&bar[XB_XSUB(b.x)], 1u);
        const unsigned gen = old / nloc;
        if (old + 1u == (gen + 1u) * nloc) {
            __builtin_amdgcn_fence(__ATOMIC_RELEASE, "agent");
            asm volatile("s_waitcnt vmcnt(0)" ::: "memory");
            const unsigned og = xb_add(&bar[XB_TOP], 1u);
            const unsigned tg = og / nx;
            if (og + 1u == (tg + 1u) * nx) xb_add(&bar[XB_TOPGEN], 1u);
            else XB_SPIN(xb_ld(&bar[XB_TOPGEN]) == tg, bar);
            __builtin_amdgcn_fence(__ATOMIC_ACQUIRE, "agent");
            xb_add(&bar[XB_XGEN(b.x)], 1u);
            asm volatile("s_waitcnt vmcnt(0)" ::: "memory");
        } else {
            XB_SPIN(xb_ld(&bar[XB_XGEN(b.x)]) == gen, bar);
            __builtin_amdgcn_fence(__ATOMIC_ACQUIRE, "agent");
            asm volatile("s_waitcnt vmcnt(0)" ::: "memory");
        }
    }
    __syncthreads();
}

namespace pg8 {
constexpr int BM = 256, BK = 64, HALF = 128, HTB = HALF * BK * 2, STAGE_BYTES = 8 * HTB, NXCD = 8, WGM = 8;
__device__ __forceinline__ int lds_byte(int r, int c) { const int st = (r >> 4) * 2 + (c >> 5), rr = r & 15, cc = c & 31, ob = rr * 64 + cc * 2; return st * 1024 + (ob ^ (((ob >> 9) & 1) << 5)); }
__device__ __forceinline__ void stage_rc(int b, int& R, int& C) { const int st = b / 1024, sb = b % 1024, swz = sb ^ (((sb >> 9) & 1) << 5); R = (st >> 1) * 16 + swz / 64; C = (st & 1) * 32 + (swz % 64) / 2; }
__device__ __forceinline__ int perm32(int rho) { const int n = rho >> 4, i = rho & 15; return 8 * (i >> 2) + 4 * n + (i & 3); }
struct Unit { int pm, pn, x0, x1; };
__device__ __forceinline__ void tile_of(int L, int nM, int nN, int& pm, int& pn) {
    const int nwg = nM * nN; int wgid = L; { const int q = nwg / NXCD, r = nwg % NXCD, xcd = wgid % NXCD, off = wgid / NXCD; wgid = (xcd < r ? xcd * (q + 1) : r * (q + 1) + (xcd - r) * q) + off; }
    const int nig = WGM * nN, gid = wgid / nig, fm = gid * WGM, gsz = (nM - fm) < WGM ? (nM - fm) : WGM;
    pm = fm + ((wgid % nig) % gsz); pn = (wgid % nig) / gsz;
}
struct PlainProb {
    static constexpr bool GATHER = false;
    const char* A; const char* Bt; unsigned lda2, ldb2; int nM, nN, G, c; int am = 1, bm = 1;
    __device__ __forceinline__ bool next(int i, Unit& u) const { const long L = (long)i * G + c; if (L >= (long)nM * nN) return false; tile_of((int)L, nM, nN, u.pm, u.pn); u.x0 = 0; u.x1 = 0; return true; }
    __device__ __forceinline__ const char* a_base(const Unit& u, int t) const { return A + (size_t)(u.pm * am) * 256 * lda2 + (size_t)t * 128; }
    __device__ __forceinline__ unsigned a_off(const Unit&, int half, int R, int C) const { return (unsigned)(half * 128 + R) * lda2 + (unsigned)C * 2u; }
    __device__ __forceinline__ const char* b_base(const Unit& u, int t) const { return Bt + (size_t)(u.pn * bm) * 256 * ldb2 + (size_t)t * 128; }
};

typedef float f32x4_ __attribute__((ext_vector_type(4)));
template <class Epi, class Prob, bool ALIGN_EPI>
__device__ __forceinline__ void gemm_phase(LAS unsigned char* lds, const int tid, const Prob& P, const Epi& E, const int nt) {
    const int wid = __builtin_amdgcn_readfirstlane(tid >> 6), lane = tid & 63, wr = wid >> 2, wc = wid & 3, fr = lane & 15, fq = lane >> 4;
    int Rs[2], Cs[2]; unsigned voffB[2];
#pragma unroll
    for (int i = 0; i < 2; ++i) { stage_rc(tid * 16 + i * 8192, Rs[i], Cs[i]); const int Rb = Epi::PERM ? (64 * (Rs[i] >> 5) + perm32(Rs[i] & 31)) : Rs[i]; voffB[i] = (unsigned)Rb * P.ldb2 + (unsigned)Cs[i] * 2u; }
    const unsigned hstepB = (Epi::PERM ? 32u : 128u) * P.ldb2;
    const unsigned ldsw = (unsigned)wid * 1024u;
    const int aoff = lds_byte(wr * 64 + fr, fq * 8), boff = lds_byte(wc * 32 + fr, fq * 8);
#define PG8_SA(b, h) (((b) * 2 + (h)) * HTB)
#define PG8_SB(b, h) ((4 + (b) * 2 + (h)) * HTB)
#define PG8_STAGE(bufoff, gbase, voff) do { _Pragma("unroll") for (int _i = 0; _i < 2; ++_i) \
        __builtin_amdgcn_global_load_lds((const unsigned*)((const char*)(gbase) + (voff)[_i]), (LAS unsigned*)(lds + (bufoff) + ldsw + _i * 8192), 16, 0, 0); } while (0)
#define PG8_LDA(dst, b, h) do { _Pragma("unroll") for (int m = 0; m < 4; ++m) _Pragma("unroll") for (int k = 0; k < 2; ++k) dst[m][k] = *(const LAS bf16x8*)(lds + PG8_SA(b, h) + aoff + m * 2048 + k * 1024); } while (0)
#define PG8_LDB(dst, b, h) do { _Pragma("unroll") for (int n = 0; n < 2; ++n) _Pragma("unroll") for (int k = 0; k < 2; ++k) dst[n][k] = *(const LAS bf16x8*)(lds + PG8_SB(b, h) + boff + n * 2048 + k * 1024); } while (0)
#define PG8_MMA(ai, bj, At, Bt) do { __builtin_amdgcn_s_setprio(1); _Pragma("unroll") for (int m = 0; m < 4; ++m) _Pragma("unroll") for (int n = 0; n < 2; ++n) _Pragma("unroll") for (int k = 0; k < 2; ++k) \
        acc[ai][bj][m][n] = __builtin_amdgcn_mfma_f32_16x16x32_bf16(Bt[n][k], At[m][k], acc[ai][bj][m][n], 0, 0, 0); __builtin_amdgcn_s_setprio(0); } while (0)
#define PG8_WAIT_V(n) asm volatile("s_waitcnt vmcnt(" #n ")" ::: "memory")
#define PG8_WAIT_L(n) asm volatile("s_waitcnt lgkmcnt(" #n ")" ::: "memory")
#define PG8_BAR __builtin_amdgcn_s_barrier()
#define PG8_SCHED __builtin_amdgcn_sched_barrier(0)
    Unit cur, nxt; int ui = 0;
#ifdef PROBE_DUP
    constexpr bool DUP = (Epi::ID == PROBE_DUP);
#else
    constexpr bool DUP = false;
#endif
    if (!P.next(0, cur)) return;
    f32x4 acc[2][2][4][2];
#pragma unroll
    for (int a = 0; a < 2; ++a)
#pragma unroll
        for (int b = 0; b < 2; ++b)
#pragma unroll
            for (int m = 0; m < 4; ++m)
#pragma unroll
                for (int n = 0; n < 2; ++n) { const float z = zero_v(); acc[a][b][m][n] = (f32x4){z, z, z, z}; }
    bf16x8 At[4][2], B0[2][2], B1[2][2];
    unsigned cA0[2], cA1[2], nA0[2], nA1[2];
#pragma unroll
    for (int i = 0; i < 2; ++i) { cA0[i] = P.a_off(cur, 0, Rs[i], Cs[i]); cA1[i] = P.a_off(cur, 1, Rs[i], Cs[i]); nA0[i] = cA0[i]; nA1[i] = cA1[i]; }
    { const char* a0 = P.a_base(cur, 0); const char* b0 = P.b_base(cur, 0); const char* a1p = P.a_base(cur, 1); const char* b1p = P.b_base(cur, 1);
      PG8_STAGE(PG8_SB(0, 0), b0, voffB); PG8_STAGE(PG8_SB(0, 1), b0 + hstepB, voffB); PG8_STAGE(PG8_SA(0, 0), a0, cA0); PG8_STAGE(PG8_SA(0, 1), a0, cA1);
      if (wr == 1) PG8_BAR;
      PG8_WAIT_V(2); PG8_BAR;
      PG8_STAGE(PG8_SB(1, 0), b1p, voffB); PG8_STAGE(PG8_SA(1, 0), a1p, cA0); PG8_STAGE(PG8_SB(1, 1), b1p + hstepB, voffB);
      PG8_WAIT_V(6); PG8_BAR; }
    for (;;) {
        const bool has_next = P.next(DUP ? ((ui + 1) >> 1) : (ui + 1), nxt);
        if (!has_next) nxt = cur;
        if constexpr (Prob::GATHER) {
#pragma unroll
            for (int i = 0; i < 2; ++i) { nA0[i] = P.a_off(nxt, 0, Rs[i], Cs[i]); nA1[i] = P.a_off(nxt, 1, Rs[i], Cs[i]); } }
        for (int t = 0; t < nt; t += 2) {
            const bool last = (t == nt - 2);
            const char* a1 = P.a_base(cur, t + 1);
            const char* a2 = last ? P.a_base(nxt, 0) : P.a_base(cur, t + 2); const char* b2 = last ? P.b_base(nxt, 0) : P.b_base(cur, t + 2);
            const char* a3 = last ? P.a_base(nxt, 1) : P.a_base(cur, t + 3); const char* b3 = last ? P.b_base(nxt, 1) : P.b_base(cur, t + 3);
            unsigned xA0[2], xA1[2];
#pragma unroll
            for (int i = 0; i < 2; ++i) { xA0[i] = (Prob::GATHER && last) ? nA0[i] : cA0[i]; xA1[i] = (Prob::GATHER && last) ? nA1[i] : cA1[i]; }
            PG8_LDB(B0, 0, 0); PG8_LDB(B1, 0, 1); PG8_SCHED; PG8_LDA(At, 0, 0); PG8_STAGE(PG8_SA(1, 1), a1, cA1);
            PG8_WAIT_V(8); PG8_WAIT_L(0); PG8_BAR; PG8_MMA(0, 0, At, B0); PG8_MMA(0, 1, At, B1); PG8_BAR; PG8_SCHED;
            PG8_LDA(At, 0, 1); PG8_STAGE(PG8_SB(0, 0), b2, voffB); PG8_STAGE(PG8_SB(0, 1), b2 + hstepB, voffB); PG8_STAGE(PG8_SA(0, 0), a2, xA0);
            PG8_WAIT_V(8); PG8_WAIT_L(0); PG8_BAR; PG8_MMA(1, 0, At, B0); PG8_MMA(1, 1, At, B1); PG8_BAR; PG8_SCHED;
            PG8_LDB(B0, 1, 0); PG8_LDB(B1, 1, 1); PG8_SCHED; PG8_LDA(At, 1, 0); PG8_STAGE(PG8_SA(0, 1), a2, xA1);
            PG8_WAIT_V(8); PG8_WAIT_L(0); PG8_BAR; PG8_MMA(0, 0, At, B0); PG8_MMA(0, 1, At, B1); PG8_BAR; PG8_SCHED;
            PG8_LDA(At, 1, 1); PG8_STAGE(PG8_SB(1, 0), b3, voffB); PG8_STAGE(PG8_SB(1, 1), b3 + hstepB, voffB); PG8_STAGE(PG8_SA(1, 0), a3, xA0);
            PG8_WAIT_V(8); PG8_WAIT_L(0); PG8_BAR; PG8_MMA(1, 0, At, B0); PG8_MMA(1, 1, At, B1); PG8_BAR; PG8_SCHED;
        }
        if constexpr (ALIGN_EPI) { if (wr == 0) PG8_BAR; }
        if (!DUP || (ui & 1)) E(acc, cur, wr, wc, fr, fq);
#ifdef PROBE_EPI2
        if constexpr (Epi::PROBE2) E(acc, cur, wr, wc, fr, fq);
#endif
        if (!has_next) break;
#pragma unroll
        for (int a = 0; a < 2; ++a)
#pragma unroll
            for (int b = 0; b < 2; ++b)
#pragma unroll
                for (int m = 0; m < 4; ++m)
#pragma unroll
                    for (int n = 0; n < 2; ++n) { const float z = zero_v(); acc[a][b][m][n] = (f32x4){z, z, z, z}; }
        cur = nxt; ++ui;
        if constexpr (Prob::GATHER) {
#pragma unroll
            for (int i = 0; i < 2; ++i) { cA0[i] = nA0[i]; cA1[i] = nA1[i]; } }
        if constexpr (ALIGN_EPI) { if (wr == 1) PG8_BAR; }
    }
    PG8_WAIT_V(0);
    if constexpr (!ALIGN_EPI) { if (wr == 0) PG8_BAR; }
    PG8_BAR;
#undef PG8_SA
#undef PG8_SB
#undef PG8_STAGE
#undef PG8_LDA
#undef PG8_LDB
#undef PG8_MMA
#undef PG8_WAIT_V
#undef PG8_WAIT_L
#undef PG8_BAR
#undef PG8_SCHED
}

__device__ __forceinline__ void store_lines(bf16_t* rowp16, int ldc, int fr, int fq, const u32x4 v0, const u32x4 v1) {
    const bool lo = fr < 8;
    u32x4 x = lo ? v1 : v0, y;
    y.x = __shfl_xor((int)x.x, 8); y.y = __shfl_xor((int)x.y, 8); y.z = __shfl_xor((int)x.z, 8); y.w = __shfl_xor((int)x.w, 8);
    bf16_t* p = rowp16 + (size_t)(fr & 7) * ldc + (lo ? 0 : 32) + 8 * fq;
#ifdef NT_STORES
    __builtin_nontemporal_store(lo ? v0 : y, (u32x4*)p);
    __builtin_nontemporal_store(lo ? y : v1, (u32x4*)(p + (size_t)8 * ldc));
#else
    *(u32x4*)p = lo ? v0 : y;
    *(u32x4*)(p + (size_t)8 * ldc) = lo ? y : v1;
#endif
}
struct EpiStore {
    static constexpr bool PERM = true, PROBE2 = true; static constexpr int ID = 1;
    bf16_t* O; int ldc; int gate_pn0; const float* gbias; int gate_col0;
    __device__ __forceinline__ void operator()(const f32x4 (&acc)[2][2][4][2], const Unit& u, int wr, int wc, int fr, int fq) const {
        const int row0 = u.pm * BM + wr * 64, colw = u.pn * BM + wc * 64, col0 = colw + 8 * fq;
        const bool gate = u.pn >= gate_pn0;
        f32x4 bv[2][2];
#pragma unroll
        for (int bj = 0; bj < 2; ++bj)
#pragma unroll
            for (int n = 0; n < 2; ++n) bv[bj][n] = gate ? *(const f32x4*)(gbias + (col0 - gate_col0) + bj * 32 + 4 * n) : (f32x4){0.f, 0.f, 0.f, 0.f};
#pragma unroll
        for (int ai = 0; ai < 2; ++ai)
#pragma unroll
            for (int m = 0; m < 4; ++m) {
                u32x4 w[2];
#pragma unroll
                for (int bj = 0; bj < 2; ++bj) { f32x4 v0 = acc[ai][bj][m][0] + bv[bj][0], v1 = acc[ai][bj][m][1] + bv[bj][1];
                    if (gate) {
#pragma unroll
                        for (int j = 0; j < 4; ++j) { v0[j] = sigmoidf_(v0[j]); v1[j] = sigmoidf_(v1[j]); } }
                    w[bj].x = pk2(v0[0], v0[1]); w[bj].y = pk2(v0[2], v0[3]); w[bj].z = pk2(v1[0], v1[1]); w[bj].w = pk2(v1[2], v1[3]); }
                store_lines(O + (size_t)(row0 + ai * HALF + m * 16) * ldc + colw, ldc, fr, fq, w[0], w[1]);
            }
    }
};
struct EpiResid {
    static constexpr bool PERM = false, PROBE2 = false; static constexpr int ID = 2;
    const float* xin; float* out; int ldc;
    __device__ __forceinline__ void operator()(const f32x4 (&acc)[2][2][4][2], const Unit& u, int wr, int wc, int fr, int fq) const {
        const int row0 = u.pm * BM + wr * 64 + fr, col0 = u.pn * BM + wc * 32 + 4 * fq;
#pragma unroll
        for (int ai = 0; ai < 2; ++ai)
#pragma unroll
            for (int m = 0; m < 4; ++m) { const size_t off = (size_t)(row0 + ai * HALF + m * 16) * ldc + col0;
#pragma unroll
                for (int bj = 0; bj < 2; ++bj)
#pragma unroll
                    for (int n = 0; n < 2; ++n) { const f32x4 bs = *(const f32x4*)(xin + off + bj * HALF + n * 16); *(f32x4*)(out + off + bj * HALF + n * 16) = bs + acc[ai][bj][m][n]; } }
    }
};
}
struct Args { const float* in[35]; float* out; unsigned char* ws; int s_lo, s_hi; };
#define AS4 __attribute__((address_space(4)))
struct InProxy { const AS4 unsigned char* ka; __device__ __forceinline__ const float* operator[](int k) const { return *(const float* const AS4*)(ka + 8 * k); } };
struct ArgsV { InProxy in; float* out; unsigned char* ws; };
struct Frame {
    LAS unsigned char* lds;
    int tid, lane, wave, vcu, G;
};

template <bool ILV = false>
__device__ __forceinline__ void tr_item(const float* src, int ld, int col0, bf16_t* dst, int dld, int drow0, int k0, int n0, float scale, const float* kscale, LAS float* scr, int lane) {
    f32x4 v[16];
#pragma unroll
    for (int i = 0; i < 16; ++i) v[i] = *(const f32x4*)(src + (size_t)(k0 + 4 * i + (lane >> 4)) * ld + col0 + n0 + 4 * (lane & 15));
#pragma unroll
    for (int i = 0; i < 16; ++i) { LAS float* d = scr + (4 * i + (lane >> 4)) * 65 + 4 * (lane & 15); d[0] = v[i].x; d[1] = v[i].y; d[2] = v[i].z; d[3] = v[i].w; }
    LDS_WAIT(); asm volatile("" ::: "memory");
    const int c = lane & 7;
    float ks[8];
#pragma unroll
    for (int q = 0; q < 8; ++q) ks[q] = kscale ? kscale[k0 + 8 * c + q] * scale : scale;
#pragma unroll
    for (int j = 0; j < 8; ++j) { const int n = (lane >> 3) + 8 * j; const LAS float* s = scr + (8 * c) * 65 + n;
        u32x4 o; o.x = pk2(s[0 * 65] * ks[0], s[1 * 65] * ks[1]); o.y = pk2(s[2 * 65] * ks[2], s[3 * 65] * ks[3]); o.z = pk2(s[4 * 65] * ks[4], s[5 * 65] * ks[5]); o.w = pk2(s[6 * 65] * ks[6], s[7 * 65] * ks[7]);
        const int nn = n0 + n, drow = ILV ? drow0 + (nn >> 5) * 64 + (nn & 31) : drow0 + nn;
        *(u32x4*)(dst + (size_t)drow * dld + k0 + 8 * c) = o; }
    LDS_WAIT(); asm volatile("" ::: "memory");
}
__device__ __forceinline__ void pool_fold_item(const float* w_in, const float* wg, const float* pscale, bf16_t* wt_in, int item, LAS float* scr, int lane) {
    const int g = item >> 6, k0 = (item & 63) * 16;
#pragma unroll
    for (int kk = 0; kk < 16; ++kk) { scr[kk * 128 + lane] = w_in[(size_t)(k0 + kk) * IN_COLS + PU + g * 128 + lane]; scr[kk * 128 + 64 + lane] = w_in[(size_t)(k0 + kk) * IN_COLS + PU + g * 128 + 64 + lane]; }
    LDS_WAIT(); asm volatile("" ::: "memory");
    float a0[16], a1[16];
#pragma unroll
    for (int kk = 0; kk < 16; ++kk) { a0[kk] = 0.f; a1[kk] = 0.f; }
    const float* wgg = wg + (size_t)g * 128 * 128;
    for (int j = 0; j < 128; ++j) { const float w0 = wgg[j * 128 + lane], w1 = wgg[j * 128 + 64 + lane];
#pragma unroll
        for (int kk = 0; kk < 16; ++kk) { const float u = scr[kk * 128 + j]; a0[kk] += u * w0; a1[kk] += u * w1; } }
    const float s0 = pscale[g * 128 + lane], s1 = pscale[g * 128 + 64 + lane];
    u32x4 o;
    bf16_t* d0 = wt_in + (size_t)(PU + g * 128 + lane) * DM + k0; bf16_t* d1 = wt_in + (size_t)(PU + g * 128 + 64 + lane) * DM + k0;
    o.x = pk2(a0[0] * s0, a0[1] * s0); o.y = pk2(a0[2] * s0, a0[3] * s0); o.z = pk2(a0[4] * s0, a0[5] * s0); o.w = pk2(a0[6] * s0, a0[7] * s0); *(u32x4*)d0 = o;
    o.x = pk2(a0[8] * s0, a0[9] * s0); o.y = pk2(a0[10] * s0, a0[11] * s0); o.z = pk2(a0[12] * s0, a0[13] * s0); o.w = pk2(a0[14] * s0, a0[15] * s0); *(u32x4*)(d0 + 8) = o;
    o.x = pk2(a1[0] * s1, a1[1] * s1); o.y = pk2(a1[2] * s1, a1[3] * s1); o.z = pk2(a1[4] * s1, a1[5] * s1); o.w = pk2(a1[6] * s1, a1[7] * s1); *(u32x4*)d1 = o;
    o.x = pk2(a1[8] * s1, a1[9] * s1); o.y = pk2(a1[10] * s1, a1[11] * s1); o.z = pk2(a1[12] * s1, a1[13] * s1); o.w = pk2(a1[14] * s1, a1[15] * s1); *(u32x4*)(d1 + 8) = o;
    LDS_WAIT(); asm volatile("" ::: "memory");
}

constexpr float QSCALE = 0.125f * LOG2E;
__device__ __forceinline__ void prep_weights(const Frame& F, const ArgsV& args, int l) {
    unsigned char* wsw = args.ws + WS_W;
    bf16_t* wt_in = (bf16_t*)(wsw + W_IN);
    LAS float* scr = (LAS float*)(F.lds + F.wave * 16640);
    const int gw = F.vcu * NWAVES + F.wave, NGW = F.G * NWAVES;
    const float* w_in = args.in[2] + (size_t)l * DM * IN_COLS;
    constexpr int I_POOL = 256, I_Q = 128, I_KV = 256, I_ZX = 320, I_G = 768, I_BR = 384, I_MIX = 256, I_XQ = 64, I_XKV = 128, I_XO = 64, I_EG = 2048, I_EU = 2048, I_ED = 2048;
    constexpr int NITEMS = I_POOL + I_Q + I_KV + I_ZX + I_G + I_BR + I_MIX + I_XQ + I_XKV + I_XO + I_EG + I_EU + I_ED;
    for (int it = gw; it < NITEMS; it += NGW) {
        int r = it;
        if (r < I_POOL) { pool_fold_item(w_in, args.in[10] + (size_t)l * 4 * 128 * 128, args.in[11] + (size_t)l * 512, wt_in, r, scr, F.lane); continue; } r -= I_POOL;
        if (r < I_Q) { tr_item(w_in, IN_COLS, 0, wt_in, DM, 0, (r / 8) * 64, (r % 8) * 64, QSCALE, nullptr, scr, F.lane); continue; } r -= I_Q;
        if (r < I_KV) { tr_item(w_in, IN_COLS, 512, wt_in, DM, 512, (r / 16) * 64, (r % 16) * 64, 1.f, nullptr, scr, F.lane); continue; } r -= I_KV;
        if (r < I_ZX) { tr_item(w_in, IN_COLS, 2048, wt_in, DM, 2048, (r / 20) * 64, (r % 20) * 64, 1.f, nullptr, scr, F.lane); continue; } r -= I_ZX;
        if (r < I_G) { tr_item(w_in, IN_COLS, COL_GATE, wt_in, DM, PG, (r / 48) * 64, (r % 48) * 64, 1.f, nullptr, scr, F.lane); continue; } r -= I_G;
        if (r < I_BR) { const int b = r / 128, q = r % 128;
            tr_item(args.in[18] + (size_t)(l * 3 + b) * 512 * 1024, 1024, 0, (bf16_t*)(wsw + W_BR) + (size_t)b * 1024 * 512, 512, 0, (q / 16) * 64, (q % 16) * 64, 1.f, b == 2 ? args.in[17] + (size_t)l * 512 : nullptr, scr, F.lane); continue; } r -= I_BR;
        if (r < I_MIX) { tr_item(args.in[19] + (size_t)l * 1024 * 1024, 1024, 0, (bf16_t*)(wsw + W_MIX), 1024, 0, (r / 16) * 64, (r % 16) * 64, 1.f, nullptr, scr, F.lane); continue; } r -= I_MIX;
        if (r < I_XQ) { tr_item(args.in[23] + (size_t)l * 1024 * 256, 256, 0, (bf16_t*)(wsw + W_XQ), 1024, 0, (r / 4) * 64, (r % 4) * 64, QSCALE, nullptr, scr, F.lane); continue; } r -= I_XQ;
        if (r < I_XKV) { tr_item(args.in[24] + (size_t)l * 1024 * 512, 512, 0, (bf16_t*)(wsw + W_XKV), 1024, 0, (r / 8) * 64, (r % 8) * 64, 1.f, nullptr, scr, F.lane); continue; } r -= I_XKV;
        if (r < I_XO) { tr_item(args.in[25] + (size_t)l * 256 * 1024, 1024, 0, (bf16_t*)(wsw + W_XO), 256, 0, (r / 16) * 64, (r % 16) * 64, 1.f, nullptr, scr, F.lane); continue; } r -= I_XO;
        if (r < I_EG + I_EU) { const int up = r >= I_EG; if (up) r -= I_EG; const int e = r / 128, q = r % 128, n0 = (q % 8) * 64;
            tr_item<true>(args.in[up ? 32 : 31] + (size_t)(l * 16 + e) * 1024 * 512, 512, 0, (bf16_t*)(wsw + W_GU), 1024, e * 1024 + (up ? 32 : 0), (q / 8) * 64, n0, 1.f, nullptr, scr, F.lane); continue; } r -= I_EG + I_EU;
        { const int e = r / 128, q = r % 128;
            tr_item(args.in[33] + (size_t)(l * 16 + e) * 512 * 1024, 1024, 0, (bf16_t*)(wsw + W_DN) + (size_t)e * 1024 * 512, 512, 0, (q / 16) * 64, (q % 16) * 64, 1.f, nullptr, scr, F.lane); }
    }
}

__device__ __forceinline__ void load_row(const float* xrow, int lane, f32x4 (&v)[4]) {
#pragma unroll
    for (int j = 0; j < 4; ++j) v[j] = ((const f32x4*)xrow + lane)[64 * j];
}
__device__ __forceinline__ void norm_apply(const f32x4 (&xv)[4], const f32x4 (&gv)[4], bf16_t* orow, int lane, f32x4 (&hv)[4]) {
    float s = 0.f;
#pragma unroll
    for (int j = 0; j < 4; ++j) s += (xv[j].x * xv[j].x + xv[j].y * xv[j].y) + (xv[j].z * xv[j].z + xv[j].w * xv[j].w);
    const float rstd = 1.0f / sqrtf(wave_sum(s) * (1.f / DM) + EPS);
    unsigned long long* o8 = (unsigned long long*)orow + lane;
#pragma unroll
    for (int j = 0; j < 4; ++j) { hv[j] = xv[j] * rstd * gv[j]; o8[64 * j] = (unsigned long long)pk2(hv[j].x, hv[j].y) | ((unsigned long long)pk2(hv[j].z, hv[j].w) << 32); }
}
__device__ __forceinline__ void load_gain(const float* g, int lane, f32x4 (&gv)[4]) {
#pragma unroll
    for (int j = 0; j < 4; ++j) gv[j] = ((const f32x4*)g + lane)[64 * j];
}
__device__ __forceinline__ void norm_rows_plain(const Frame& F, const float* x, const float* g, bf16_t* H, int nrows) {
    const int gw = F.vcu * NWAVES + F.wave, NGW = F.G * NWAVES;
    f32x4 gv[4], hv[4], cur[4], nxt[4]; load_gain(g, F.lane, gv);
    if (gw < nrows) load_row(x + (size_t)gw * DM, F.lane, cur);
    for (int m = gw; m < nrows; m += NGW) {
        const int mn = (m + NGW < nrows) ? m + NGW : m;
        load_row(x + (size_t)mn * DM, F.lane, nxt);
        norm_apply(cur, gv, H + (size_t)m * DM, F.lane, hv);
#pragma unroll
        for (int j = 0; j < 4; ++j) cur[j] = nxt[j];
    }
}
__device__ __forceinline__ void norm_rows_dt(const Frame& F, const float* x, const float* g, bf16_t* H, const float* w_in, float* DT) {
    const int gw = F.vcu * NWAVES + F.wave, NGW = F.G * NWAVES, lane = F.lane;
    f32x4 gv[4], hv[4], cur[4], nxt[4]; load_gain(g, lane, gv);
    f32x4 wd[4][4][2];
#pragma unroll
    for (int j = 0; j < 4; ++j)
#pragma unroll
        for (int i = 0; i < 4; ++i) { const float* p = w_in + (size_t)(4 * lane + 256 * j + i) * IN_COLS + COL_DT; wd[j][i][0] = *(const f32x4*)p; wd[j][i][1] = *(const f32x4*)(p + 4); }
    if (gw < T) load_row(x + (size_t)gw * DM, lane, cur);
    const bool hi = lane >= 32, b4 = (lane >> 4) & 1, b3 = (lane >> 3) & 1;
    for (int m = gw; m < T; m += NGW) {
        const int mn = (m + NGW < T) ? m + NGW : m;
        load_row(x + (size_t)mn * DM, lane, nxt);
        norm_apply(cur, gv, H + (size_t)m * DM, lane, hv);
        f32x4 d0 = {0.f, 0.f, 0.f, 0.f}, d1 = {0.f, 0.f, 0.f, 0.f};
#pragma unroll
        for (int j = 0; j < 4; ++j)
#pragma unroll
            for (int i = 0; i < 4; ++i) { d0 += wd[j][i][0] * hv[j][i]; d1 += wd[j][i][1] * hv[j][i]; }
        float a[4];
#pragma unroll
        for (int q = 0; q < 4; ++q) { const float keep = hi ? d1[q] : d0[q], send = hi ? d0[q] : d1[q]; a[q] = keep + __shfl_xor(send, 32); }
        float b[2];
#pragma unroll
        for (int q = 0; q < 2; ++q) { const float keep = b4 ? a[2 + q] : a[q], send = b4 ? a[q] : a[2 + q]; b[q] = keep + __shfl_xor(send, 16); }
        float c = (b3 ? b[1] : b[0]) + __shfl_xor(b3 ? b[0] : b[1], 8);
        c += __shfl_xor(c, 4); c += __shfl_xor(c, 2); c += __shfl_xor(c, 1);
        if ((lane & 7) == 0) DT[(size_t)m * 8 + (hi ? 4 : 0) + (b4 ? 2 : 0) + (b3 ? 1 : 0)] = c;
#pragma unroll
        for (int j = 0; j < 4; ++j) cur[j] = nxt[j];
    }
}
typedef short v4i16_t __attribute__((ext_vector_type(4)));
__device__ __forceinline__ int crow(int r, int hi) { return (r & 3) + 8 * (r >> 2) + 4 * hi; }
__device__ __forceinline__ s16x4 vtr(const LAS unsigned char* p) { return __builtin_bit_cast(s16x4, __builtin_amdgcn_ds_read_tr16_b64_v4i16((LAS v4i16_t*)p)); }

template <int NMAPS, int DV, bool DIFF> __host__ __device__ constexpr int attn_off_bt() { return 2 * 64 * (DIFF ? NMAPS * 128 : NMAPS * 128 + 16) + 2 * 64 * (DIFF ? DV * 2 : DV * 2 + 64) + 8 * 64 * 4; }
template <int NMAPS, int DV, bool DIFF>
__device__ __forceinline__ void attn_unit(LAS unsigned char* lds, const int tid_in,
                                          const bf16_t* Qp, const int ldq, const bf16_t* Kp, const bf16_t* Vp, const int ldkv, bf16_t* Op, const int ldo,
                                          const int ntiles, const int q0, const float lam, const float* subg, const float oscale) {
    constexpr bool DMA = DIFF;
    constexpr int KP = DMA ? NMAPS * 128 : NMAPS * 128 + 16, VP = DMA ? DV * 2 : DV * 2 + 64, KT = 64 * KP, VT = 64 * VP;
    static_assert(!DMA || (NMAPS == 2 && DV == 128), "DMA path is written for 256-byte K and V rows");
    static_assert(attn_off_bt<NMAPS, DV, DIFF>() == 2 * KT + 2 * VT + 8 * 64 * 4, "bias table offset");
    constexpr int KCH = NMAPS * 8, VCH = DV / 8, KN = (64 * KCH) / NTHR, VN = (64 * VCH) / NTHR, NDV = DV / 32;
    constexpr int OFF_K = 0, OFF_V = 2 * KT, OFF_SC = 2 * KT + 2 * VT, OFF_BT = OFF_SC + 8 * 64 * 4, OFF_Q = OFF_BT + 1024;
    constexpr bool QLDS = DIFF;
    static_assert(OFF_Q + (QLDS ? 256 * KP : 0) <= RING_BYTES, "attention LDS");
    int tid = tid_in; asm volatile("" : "+v"(tid));
    const int lane = tid & 63, wave = __builtin_amdgcn_readfirstlane(tid >> 6), r32 = lane & 31, hi = lane >> 5;
    LAS float* sc = (LAS float*)(lds + OFF_SC) + wave * 64;
    const LAS float* btab = (const LAS float*)(lds + OFF_BT);
    bf16x8 qf[QLDS ? 1 : NMAPS][4];
    const LAS unsigned char* qb_ = lds + OFF_Q + (wave * 32 + r32) * KP + (DMA ? 0 : hi * 16);
    const int xsw = r32 & 15;
    if constexpr (QLDS) {
#pragma unroll
        for (int i = 0; i < (32 * KCH) / 64; ++i) { const int c_ = lane + i * 64, row_ = c_ / KCH, ch_ = c_ % KCH;
            *(LAS u32x4*)(lds + OFF_Q + (wave * 32 + row_) * KP + ((DMA ? (ch_ ^ (row_ & 15)) : ch_) * 16)) = *(const u32x4*)(Qp + (size_t)(wave * 32 + row_) * ldq + ch_ * 8); }
    } else {
#pragma unroll
        for (int m = 0; m < NMAPS; ++m)
#pragma unroll
            for (int d0 = 0; d0 < 4; ++d0) qf[m][d0] = *(const bf16x8*)(Qp + (size_t)(wave * 32 + r32) * ldq + m * 64 + d0 * 16 + hi * 8);
    }
    f32x16 O[NMAPS][NDV];
#pragma unroll
    for (int m = 0; m < NMAPS; ++m)
#pragma unroll
        for (int d = 0; d < NDV; ++d)
            { const float z = zero_v();
#pragma unroll
            for (int r = 0; r < 16; ++r) O[m][d][r] = z; }
    float mrun[NMAPS], lrun[NMAPS];
#pragma unroll
    for (int m = 0; m < NMAPS; ++m) { mrun[m] = -INFINITY; lrun[m] = 0.f; }
    const int my_last = DIFF ? (q0 + 32 * wave) / 64 : ntiles - 1;
    const int qpos = q0 + 32 * wave + r32;
    u32x4 kreg[DMA ? 1 : KN], vreg[DMA ? 1 : VN];
    unsigned dko[2], dvo[2];
    if constexpr (DMA) {
#pragma unroll
        for (int ii = 0; ii < 2; ++ii) { const int row_ = 4 * (2 * wave + ii) + (lane >> 4), p_ = lane & 15;
            dko[ii] = (unsigned)(row_ * ldkv + ((p_ ^ (row_ & 15)) * 8)) * 2u; dvo[ii] = (unsigned)(row_ * ldkv + ((p_ ^ ((row_ & 3) << 2)) * 8)) * 2u; }
    }
#define ATT_LOAD(j) do { if constexpr (!DMA) { _Pragma("unroll") for (int i_ = 0; i_ < KN; ++i_) { const int c_ = tid + i_ * NTHR, row_ = c_ / KCH, ch_ = c_ % KCH; kreg[i_] = *(const u32x4*)(Kp + (size_t)((j) * 64 + row_) * ldkv + ch_ * 8); } \
        _Pragma("unroll") for (int i_ = 0; i_ < VN; ++i_) { const int c_ = tid + i_ * NTHR, row_ = c_ / VCH, ch_ = c_ % VCH; vreg[i_] = *(const u32x4*)(Vp + (size_t)((j) * 64 + row_) * ldkv + ch_ * 8); } } } while (0)
#define ATT_WRITE(buf) do { if constexpr (!DMA) { _Pragma("unroll") for (int i_ = 0; i_ < KN; ++i_) { const int c_ = tid + i_ * NTHR, row_ = c_ / KCH, ch_ = c_ % KCH; *(LAS u32x4*)(lds + OFF_K + (buf) * KT + row_ * KP + ch_ * 16) = kreg[i_]; } \
        _Pragma("unroll") for (int i_ = 0; i_ < VN; ++i_) { const int c_ = tid + i_ * NTHR, row_ = c_ / VCH, ch_ = c_ % VCH; *(LAS u32x4*)(lds + OFF_V + (buf) * VT + row_ * VP + ch_ * 16) = vreg[i_]; } } } while (0)
#define ATT_DMA(j, buf) do { if constexpr (DMA) { const char* kt_ = (const char*)(Kp + (size_t)(j) * 64 * ldkv); const char* vt_ = (const char*)(Vp + (size_t)(j) * 64 * ldkv); \
        _Pragma("unroll") for (int ii = 0; ii < 2; ++ii) { \
            __builtin_amdgcn_global_load_lds((const unsigned*)(kt_ + dko[ii]), (LAS unsigned*)(lds + OFF_K + (buf) * KT + (2 * wave + ii) * 1024), 16, 0, 0); \
            __builtin_amdgcn_global_load_lds((const unsigned*)(vt_ + dvo[ii]), (LAS unsigned*)(lds + OFF_V + (buf) * VT + (2 * wave + ii) * 1024), 16, 0, 0); } } } while (0)
    ATT_LOAD(0); ATT_WRITE(0); ATT_DMA(0, 0);
    __syncthreads();
    for (int j = 0; j < ntiles; ++j) {
        if (j + 1 < ntiles) { ATT_LOAD(j + 1); ATT_DMA(j + 1, (j + 1) & 1); }
        if (j <= my_last) {
            const LAS unsigned char* kb = lds + OFF_K + (j & 1) * KT + r32 * KP + (DMA ? 0 : hi * 16);
            const int qv4 = (lane & 15) >> 2;
            const LAS unsigned char* vb = lds + OFF_V + (j & 1) * VT + (4 * hi + qv4) * VP + (16 * ((lane >> 4) & 1) + 4 * (lane & 3)) * 2;
#pragma unroll
            for (int m = 0; m < NMAPS; ++m) {
                __builtin_amdgcn_sched_barrier(0);
                f32x16 s0, s1; bf16x8 pf[4];
                { const float z = zero_v();
#pragma unroll
                for (int r = 0; r < 16; ++r) { s0[r] = z; s1[r] = z; } }
#pragma unroll
                for (int d0 = 0; d0 < 4; ++d0) {
                    const int co = DMA ? (((m * 8 + d0 * 2 + hi) ^ xsw) << 4) : (m * 128 + d0 * 32);
                    const bf16x8 k0 = *(const LAS bf16x8*)(kb + co);
                    const bf16x8 k1 = *(const LAS bf16x8*)(kb + 32 * KP + co);
                    bf16x8 qv; if constexpr (QLDS) qv = *(const LAS bf16x8*)(qb_ + co); else qv = qf[m][d0];
                    s0 = __builtin_amdgcn_mfma_f32_32x32x16_bf16(k0, qv, s0, 0, 0, 0);
                    s1 = __builtin_amdgcn_mfma_f32_32x32x16_bf16(k1, qv, s1, 0, 0, 0);
                }
                __builtin_amdgcn_sched_barrier(0);
                float bfar = 0.f;
                if (DIFF) {
                    if (64 * j + 63 - (q0 + 32 * wave) <= -91) bfar = btab[0];
                    else {
                        const int relb = 64 * j + 4 * hi - qpos + 192;
#pragma unroll
                        for (int r = 0; r < 16; ++r) { const int ix = relb + (r & 3) + 8 * (r >> 2); s0[r] += btab[ix]; s1[r] += btab[ix + 32]; }
                    }
                }
                float mx = fmaxf(fmaxf(s0[0], s0[1]), s1[0]), mx2 = fmaxf(fmaxf(s0[2], s0[3]), s1[1]);
                mx = fmaxf(fmaxf(mx, s1[2]), s1[3]);
#pragma unroll
                for (int r = 4; r < 16; r += 4) { mx = fmaxf(fmaxf(mx, s0[r]), s0[r + 1]); mx2 = fmaxf(fmaxf(mx2, s0[r + 2]), s0[r + 3]); mx = fmaxf(fmaxf(mx, s1[r]), s1[r + 1]); mx2 = fmaxf(fmaxf(mx2, s1[r + 2]), s1[r + 3]); }
                mx = fmaxf(mx, mx2);
                mx = fmaxf(mx, __shfl_xor(mx, 32)) + bfar;
                const float mnew = fmaxf(mrun[m], mx);
                const float alpha = __builtin_amdgcn_exp2f(mrun[m] - mnew);
                mrun[m] = mnew;
                const float cref = mnew - bfar;
                float rs = 0.f, rs2 = 0.f;
#pragma unroll
                for (int r = 0; r < 16; ++r) { s0[r] = __builtin_amdgcn_exp2f(s0[r] - cref); s1[r] = __builtin_amdgcn_exp2f(s1[r] - cref); rs += s0[r]; rs2 += s1[r]; }
                rs += rs2;
                rs += __shfl_xor(rs, 32);
                lrun[m] = lrun[m] * alpha + rs;
                if (__builtin_amdgcn_ballot_w64(alpha != 1.0f) != 0ull) {
                    sc[lane] = alpha;
#pragma unroll
                    for (int r = 0; r < 16; ++r) { const float f = sc[crow(r, hi)];
#pragma unroll
                        for (int d = 0; d < NDV; ++d) O[m][d][r] *= f; }
                }
                __builtin_amdgcn_sched_barrier(0);
                u32x4 w;
                w.x = pk2(s0[0], s0[1]); w.y = pk2(s0[2], s0[3]); w.z = pk2(s0[4], s0[5]); w.w = pk2(s0[6], s0[7]); pf[0] = __builtin_bit_cast(bf16x8, w);
                w.x = pk2(s0[8], s0[9]); w.y = pk2(s0[10], s0[11]); w.z = pk2(s0[12], s0[13]); w.w = pk2(s0[14], s0[15]); pf[1] = __builtin_bit_cast(bf16x8, w);
                w.x = pk2(s1[0], s1[1]); w.y = pk2(s1[2], s1[3]); w.z = pk2(s1[4], s1[5]); w.w = pk2(s1[6], s1[7]); pf[2] = __builtin_bit_cast(bf16x8, w);
                w.x = pk2(s1[8], s1[9]); w.y = pk2(s1[10], s1[11]); w.z = pk2(s1[12], s1[13]); w.w = pk2(s1[14], s1[15]); pf[3] = __builtin_bit_cast(bf16x8, w);
                __builtin_amdgcn_sched_barrier(0);
#pragma unroll
                for (int ks = 0; ks < 4; ++ks)
#pragma unroll
                    for (int d = 0; d < NDV; ++d) {
                        const int vo = DMA ? ((d ^ qv4) << 6) : d * 64;
                        const s16x4 lo = vtr(vb + (16 * ks) * VP + vo), hh = vtr(vb + (16 * ks + 8) * VP + vo);
                        const bf16x8 vf = (bf16x8){lo[0], lo[1], lo[2], lo[3], hh[0], hh[1], hh[2], hh[3]};
                        O[m][d] = __builtin_amdgcn_mfma_f32_32x32x16_bf16(pf[ks], vf, O[m][d], 0, 0, 0);
                    }
            }
        }
        if (j + 1 < ntiles) ATT_WRITE((j + 1) & 1);
        __syncthreads();
    }
#undef ATT_LOAD
#undef ATT_WRITE
#undef ATT_DMA
    int lane_e = lane; asm volatile("" : "+v"(lane_e));
    const int r32e = lane_e & 31, hie = lane_e >> 5;
    float a0[16], a1[16];
    sc[lane_e] = 1.0f / lrun[0];
#pragma unroll
    for (int r = 0; r < 16; ++r) a0[r] = sc[crow(r, hie)];
    if (NMAPS == 2) {
        sc[lane_e] = lam / lrun[NMAPS - 1];
#pragma unroll
        for (int r = 0; r < 16; ++r) a1[r] = sc[crow(r, hie)];
    }
#pragma unroll
    for (int d = 0; d < NDV; ++d)
#pragma unroll
        for (int r = 0; r < 16; ++r) O[0][d][r] = (NMAPS == 2) ? (O[0][d][r] * a0[r] - O[NMAPS - 1][d][r] * a1[r]) : O[0][d][r] * a0[r];
#define y O[0]
    if (DIFF) {
        float gg[NDV];
#pragma unroll
        for (int d = 0; d < NDV; ++d) gg[d] = subg[32 * d + r32e] * oscale;
#pragma unroll
        for (int r = 0; r < 16; ++r) {
            float ss = 0.f;
#pragma unroll
            for (int d = 0; d < NDV; ++d) ss += y[d][r] * y[d][r];
            ss += __shfl_xor(ss, 1); ss += __shfl_xor(ss, 2); ss += __shfl_xor(ss, 4); ss += __shfl_xor(ss, 8); ss += __shfl_xor(ss, 16);
            const float rstd = __builtin_amdgcn_rsqf(ss * (1.0f / DV) + EPS);
#pragma unroll
            for (int d = 0; d < NDV; ++d) y[d][r] *= rstd * gg[d];
        }
    }
#pragma unroll
    for (int r = 0; r < 16; ++r) {
        bf16_t* orow = Op + (size_t)(wave * 32 + crow(r, hie)) * ldo + r32e;
#pragma unroll
        for (int d = 0; d < NDV; ++d) orow[32 * d] = (bf16_t)f2bf(y[d][r]);
    }
#undef y
    __syncthreads();
}

__device__ __forceinline__ int rel_bucket(int rel) {
    const int n = rel < 0 ? -rel : rel; int b;
    if (n < 8) b = n; else { b = 8 + (n >= 12) + (n >= 16) + (n >= 23) + (n >= 32) + (n >= 46) + (n >= 64) + (n >= 91); }
    return (rel > 0 ? 16 : 0) + b;
}
__device__ __forceinline__ int swz128(int row, int cb) { return row * 128 + (cb ^ (((row >> 1) & 1) << 6)); }
constexpr int SSD_CS = 0, SSD_DTL = 2048;

__device__ __forceinline__ void ssd_dt(const Frame& F, const ArgsV& args, int l, int tb, const float* DT) {
    LAS float* CS = (LAS float*)(F.lds + SSD_CS); LAS float* DTL = (LAS float*)(F.lds + SSD_DTL);
    const int h = F.wave, ll = F.lane;
    const float x = DT[(size_t)(tb + ll) * 8 + h] + args.in[14][l * 8 + h];
    const float dtv = fmaxf(x, 0.f) + log1pf(__expf(-fabsf(x)));
    const float A = -__expf(args.in[15][l * 8 + h]);
    float v = dtv * A;
#pragma unroll
    for (int o = 1; o < 64; o <<= 1) { const float n = __shfl_up(v, o); if (ll >= o) v += n; }
    CS[h * 64 + ll] = v; DTL[h * 64 + ll] = dtv;
}
__device__ __forceinline__ void ssd_conv8(const ArgsV& args, int l, const bf16_t* proj, int tb, int ll, int spos, int col0, float (&o)[8]) {
    const float* cw = args.in[12] + (size_t)l * 4 * 768 + col0; const float* cb = args.in[13] + (size_t)l * 768 + col0;
    { const f32x4 b0 = *(const f32x4*)cb, b1 = *(const f32x4*)(cb + 4); o[0] = b0[0]; o[1] = b0[1]; o[2] = b0[2]; o[3] = b0[3]; o[4] = b1[0]; o[5] = b1[1]; o[6] = b1[2]; o[7] = b1[3]; }
#pragma unroll
    for (int j = 0; j < 4; ++j) {
        if (spos - 3 + j >= 0) {
            const u32x4 xv = *(const u32x4*)(proj + (size_t)(tb + ll - 3 + j) * PC + PX + col0);
            const f32x4 w0 = *(const f32x4*)(cw + j * 768), w1 = *(const f32x4*)(cw + j * 768 + 4);
            o[0] += w0[0] * bf_lo(xv.x); o[1] += w0[1] * bf_hi(xv.x); o[2] += w0[2] * bf_lo(xv.y); o[3] += w0[3] * bf_hi(xv.y);
            o[4] += w1[0] * bf_lo(xv.z); o[5] += w1[1] * bf_hi(xv.z); o[6] += w1[2] * bf_lo(xv.w); o[7] += w1[3] * bf_hi(xv.w);
        }
    }
#pragma unroll
    for (int e = 0; e < 8; ++e) o[e] = siluf_(o[e]);
}
__device__ __forceinline__ u32x4 pack8(const float (&o)[8], float s) { u32x4 w; w.x = pk2(o[0] * s, o[1] * s); w.y = pk2(o[2] * s, o[3] * s); w.z = pk2(o[4] * s, o[5] * s); w.w = pk2(o[6] * s, o[7] * s); return w; }
__device__ __forceinline__ bf16x8 trfrag(const LAS unsigned char* tile, int row, int cb) {
    const s16x4 lo = vtr(tile + swz128(row, cb)), hh = vtr(tile + swz128(row + 4, cb));
    return (bf16x8){lo[0], lo[1], lo[2], lo[3], hh[0], hh[1], hh[2], hh[3]};
}
__device__ __forceinline__ bf16x8 trfrag8(const LAS unsigned char* tile, int row, int cb) {
    const s16x4 lo = vtr(tile + swz128(row, cb)), hh = vtr(tile + swz128(row + 8, cb));
    return (bf16x8){lo[0], lo[1], lo[2], lo[3], hh[0], hh[1], hh[2], hh[3]};
}

__device__ __forceinline__ void ssd_local(const Frame& F, const ArgsV& args, int l, int item) {
    constexpr int OFF_BS = 4096, OFF_XD = 4096 + 2 * 8192;
    const bf16_t* proj = (const bf16_t*)(args.ws + WS_PROJ); const float* DT = (const float*)(args.ws + WS_DT);
    float* STATES = (float*)(args.ws + WS_STATES); float* DEC = (float*)(args.ws + WS_DEC);
    const int b = item >> 5, c = item & 31, tb = b * SEQ + c * 64, lane = F.lane, hi = lane >> 5, r32 = lane & 31;
    const LAS float* CS = (const LAS float*)(F.lds + SSD_CS); const LAS float* DTL = (const LAS float*)(F.lds + SSD_DTL);
    ssd_dt(F, args, l, tb, DT);
    __syncthreads();
    for (int i = 0; i < 10; ++i) {
        const int t_ = F.tid + i * NTHR, ll = t_ / 80, ch = t_ % 80;
        const int col0 = ch < 64 ? ch * 8 : 512 + (ch - 64) * 8;
        float o[8]; ssd_conv8(args, l, proj, tb, ll, c * 64 + ll, col0, o);
        if (ch < 64) { const int h = ch >> 3; const float s = DTL[h * 64 + ll] * __expf(CS[h * 64 + 63] - CS[h * 64 + ll]);
            *(LAS u32x4*)(F.lds + OFF_XD + h * 8192 + swz128(ll, (ch & 7) * 16)) = pack8(o, s); }
        else { const int g = (ch - 64) >> 3; *(LAS u32x4*)(F.lds + OFF_BS + g * 8192 + swz128(ll, ((ch - 64) & 7) * 16)) = pack8(o, 1.f); }
    }
    __syncthreads();
    {
        const int h = F.wave, g = h >> 2;
        const LAS unsigned char* xd = F.lds + OFF_XD + h * 8192; const LAS unsigned char* bs = F.lds + OFF_BS + g * 8192;
        const int q = (lane & 15) >> 2, cbl = (16 * ((lane >> 4) & 1) + 4 * (lane & 3)) * 2;
        f32x16 acc[2][2];
#pragma unroll
        for (int a = 0; a < 2; ++a)
#pragma unroll
            for (int n = 0; n < 2; ++n)
                { const float z = zero_v();
#pragma unroll
                for (int r = 0; r < 16; ++r) acc[a][n][r] = z; }
#pragma unroll
        for (int ks = 0; ks < 4; ++ks) {
            bf16x8 af[2], bf[2];
#pragma unroll
            for (int pb = 0; pb < 2; ++pb) { af[pb] = trfrag(xd, 16 * ks + 8 * hi + q, pb * 64 + cbl); bf[pb] = trfrag(bs, 16 * ks + 8 * hi + q, pb * 64 + cbl); }
#pragma unroll
            for (int pb = 0; pb < 2; ++pb)
#pragma unroll
                for (int nb = 0; nb < 2; ++nb) acc[pb][nb] = __builtin_amdgcn_mfma_f32_32x32x16_bf16(af[pb], bf[nb], acc[pb][nb], 0, 0, 0);
        }
        float* st = STATES + (size_t)((b * 32 + c) * 8 + h) * 4096;
#pragma unroll
        for (int pb = 0; pb < 2; ++pb)
#pragma unroll
            for (int nb = 0; nb < 2; ++nb)
#pragma unroll
                for (int r = 0; r < 16; ++r) st[(32 * pb + crow(r, hi)) * 64 + 32 * nb + r32] = acc[pb][nb][r];
        if (lane == 0) DEC[(b * 32 + c) * 8 + h] = __expf(CS[h * 64 + 63]);
    }
    __syncthreads();
}
__device__ __forceinline__ void ssd_scan(const Frame& F, const ArgsV& args) {
    float* STATES = (float*)(args.ws + WS_STATES); const float* DEC = (const float*)(args.ws + WS_DEC);
    for (int gid = F.vcu * NTHR + F.tid; gid < 128 * 1024; gid += F.G * NTHR) {
        const int bh = gid >> 10, e4 = gid & 1023, b = bh >> 3, h = bh & 7;
        f32x4 hreg = {0.f, 0.f, 0.f, 0.f};
#pragma unroll 1
        for (int half = 0; half < 2; ++half) {
            f32x4 s[16]; float d[16];
#pragma unroll
            for (int cc = 0; cc < 16; ++cc) { const int c = half * 16 + cc; s[cc] = *(const f32x4*)(STATES + (size_t)((b * 32 + c) * 8 + h) * 4096 + e4 * 4); d[cc] = DEC[(b * 32 + c) * 8 + h]; }
#pragma unroll
            for (int cc = 0; cc < 16; ++cc) { const int c = half * 16 + cc; *(f32x4*)(STATES + (size_t)((b * 32 + c) * 8 + h) * 4096 + e4 * 4) = hreg; hreg = hreg * d[cc] + s[cc]; }
        }
    }
}
__device__ __forceinline__ void ssd_out(const Frame& F, const ArgsV& args, int l, int item) {
    constexpr int OFF_BS = 4096, OFF_CS = OFF_BS + 2 * 9216, OFF_XS = OFF_CS + 2 * 9216;
    bf16_t* proj = (bf16_t*)(args.ws + WS_PROJ); const float* DT = (const float*)(args.ws + WS_DT);
    const float* STATES = (const float*)(args.ws + WS_STATES); float* SSQ = (float*)(args.ws + WS_SSQ);
    const int b = item >> 5, c = item & 31, tb = b * SEQ + c * 64, lane = F.lane, hi = lane >> 5, r32 = lane & 31;
    const LAS float* CS = (const LAS float*)(F.lds + SSD_CS); const LAS float* DTL = (const LAS float*)(F.lds + SSD_DTL);
    ssd_dt(F, args, l, tb, DT);
    __syncthreads();
    for (int i = 0; i < 12; ++i) {
        const int t_ = F.tid + i * NTHR, ll = t_ / 96, ch = t_ % 96;
        float o[8]; ssd_conv8(args, l, proj, tb, ll, c * 64 + ll, ch * 8, o);
        if (ch < 64) { const int h = ch >> 3; *(LAS u32x4*)(F.lds + OFF_XS + h * 8192 + swz128(ll, (ch & 7) * 16)) = pack8(o, 1.f); }
        else if (ch < 80) { const int g = (ch - 64) >> 3; *(LAS u32x4*)(F.lds + OFF_BS + g * 9216 + ll * 144 + ((ch - 64) & 7) * 16) = pack8(o, 1.f); }
        else { const int g = (ch - 80) >> 3; *(LAS u32x4*)(F.lds + OFF_CS + g * 9216 + ll * 144 + ((ch - 80) & 7) * 16) = pack8(o, 1.f); }
    }
    __syncthreads();
    {
        const int h = F.wave, g = h >> 2;
        const LAS unsigned char* xs = F.lds + OFF_XS + h * 8192; const LAS unsigned char* bs = F.lds + OFF_BS + g * 9216; const LAS unsigned char* cs_t = F.lds + OFF_CS + g * 9216;
        const int q = (lane & 15) >> 2, cbl = (16 * ((lane >> 4) & 1) + 4 * (lane & 3)) * 2;
        const LAS float* csh = CS + h * 64; const LAS float* dth = DTL + h * 64;
        bf16x8 Mf[3][2];
#pragma unroll
        for (int blk = 0; blk < 3; ++blk) {
            const int sb = blk >> 1, lb = (blk + 1) >> 1;
            f32x16 xt;
            { const float z = zero_v();
#pragma unroll
            for (int r = 0; r < 16; ++r) xt[r] = z; }
#pragma unroll
            for (int ks = 0; ks < 4; ++ks) {
                const bf16x8 a = *(const LAS bf16x8*)(bs + (32 * sb + r32) * 144 + (16 * ks + 8 * hi) * 2);
                const bf16x8 bq = *(const LAS bf16x8*)(cs_t + (32 * lb + r32) * 144 + (16 * ks + 8 * hi) * 2);
                xt = __builtin_amdgcn_mfma_f32_32x32x16_bf16(a, bq, xt, 0, 0, 0);
            }
            const int lpos = 32 * lb + r32; const float csl = csh[lpos];
#pragma unroll
            for (int r = 0; r < 16; ++r) { const int s = 32 * sb + crow(r, hi); xt[r] = (s <= lpos) ? xt[r] * __expf(csl - csh[s]) * dth[s] : 0.f; }
            u32x4 w;
            w.x = pk2(xt[0], xt[1]); w.y = pk2(xt[2], xt[3]); w.z = pk2(xt[4], xt[5]); w.w = pk2(xt[6], xt[7]); Mf[blk][0] = __builtin_bit_cast(bf16x8, w);
            w.x = pk2(xt[8], xt[9]); w.y = pk2(xt[10], xt[11]); w.z = pk2(xt[12], xt[13]); w.w = pk2(xt[14], xt[15]); Mf[blk][1] = __builtin_bit_cast(bf16x8, w);
        }
        f32x16 acc[2][2];
#pragma unroll
        for (int a = 0; a < 2; ++a)
#pragma unroll
            for (int n = 0; n < 2; ++n)
                { const float z = zero_v();
#pragma unroll
                for (int r = 0; r < 16; ++r) acc[a][n][r] = z; }
        const float* hin = STATES + (size_t)((b * 32 + c) * 8 + h) * 4096;
#pragma unroll
        for (int ks = 0; ks < 4; ++ks) {
            bf16x8 cf[2], hf[2];
#pragma unroll
            for (int x = 0; x < 2; ++x) {
                cf[x] = *(const LAS bf16x8*)(cs_t + (32 * x + r32) * 144 + (16 * ks + 8 * hi) * 2);
                const float* hp = hin + (32 * x + r32) * 64 + 16 * ks + 8 * hi; const f32x4 h0 = *(const f32x4*)hp, h1 = *(const f32x4*)(hp + 4);
                u32x4 w; w.x = pk2(h0[0], h0[1]); w.y = pk2(h0[2], h0[3]); w.z = pk2(h1[0], h1[1]); w.w = pk2(h1[2], h1[3]); hf[x] = __builtin_bit_cast(bf16x8, w);
            }
#pragma unroll
            for (int lb = 0; lb < 2; ++lb)
#pragma unroll
                for (int pb = 0; pb < 2; ++pb) acc[lb][pb] = __builtin_amdgcn_mfma_f32_32x32x16_bf16(cf[lb], hf[pb], acc[lb][pb], 0, 0, 0);
        }
#pragma unroll
        for (int lb = 0; lb < 2; ++lb)
#pragma unroll
            for (int r = 0; r < 16; ++r) { const float e = __expf(csh[32 * lb + crow(r, hi)]); acc[lb][0][r] *= e; acc[lb][1][r] *= e; }
#pragma unroll
        for (int blk = 0; blk < 3; ++blk) {
            const int sb = blk >> 1, lb = (blk + 1) >> 1;
#pragma unroll
            for (int s2 = 0; s2 < 2; ++s2)
#pragma unroll
                for (int pb = 0; pb < 2; ++pb) {
                    const bf16x8 xf = trfrag8(xs, 32 * sb + 16 * s2 + 4 * hi + q, pb * 64 + cbl);
                    acc[lb][pb] = __builtin_amdgcn_mfma_f32_32x32x16_bf16(Mf[blk][s2], xf, acc[lb][pb], 0, 0, 0);
                }
        }
        const float Dh = args.in[16][l * 8 + h];
#pragma unroll
        for (int lb = 0; lb < 2; ++lb)
#pragma unroll
            for (int r = 0; r < 16; ++r) {
                const int lpos = 32 * lb + crow(r, hi); const size_t t = (size_t)(tb + lpos);
                float sq = 0.f;
#pragma unroll
                for (int pb = 0; pb < 2; ++pb) {
                    const int p = 32 * pb + r32;
                    const float xv = bf2f(*(const LAS bf16_t*)(xs + swz128(lpos, p * 2)));
                    const float zv = bf2f(proj[t * PC + PZ + h * 64 + p]);
                    const float yz = (acc[lb][pb][r] + Dh * xv) * siluf_(zv);
                    proj[t * PC + PV + h * 64 + p] = (bf16_t)f2bf(yz);
                    sq += yz * yz;
                }
                sq += __shfl_xor(sq, 1); sq += __shfl_xor(sq, 2); sq += __shfl_xor(sq, 4); sq += __shfl_xor(sq, 8); sq += __shfl_xor(sq, 16);
                if (r32 == 0) SSQ[t * 8 + h] = sq;
            }
    }
    __syncthreads();
}
__device__ __forceinline__ void unpack8(const u32x4 v, float (&f)[8]) { f[0] = bf_lo(v.x); f[1] = bf_hi(v.x); f[2] = bf_lo(v.y); f[3] = bf_hi(v.y); f[4] = bf_lo(v.z); f[5] = bf_hi(v.z); f[6] = bf_lo(v.w); f[7] = bf_hi(v.w); }
template <int W>
__device__ __forceinline__ void pool_task(bf16_t* proj, int r0, int s0, int col) {
    constexpr int R = 8; u32x4 win[W - 1 + R];
#pragma unroll
    for (int k = 0; k < W - 1 + R; ++k) { const bool valid = (s0 - (W - 1) + k) >= 0; win[k] = (u32x4){0u, 0u, 0u, 0u}; if (valid) win[k] = *(const u32x4*)(proj + (size_t)(r0 - (W - 1) + k) * PC + PU + col); }
    float sum[8];
#pragma unroll
    for (int e = 0; e < 8; ++e) sum[e] = 0.f;
#pragma unroll
    for (int k = 0; k < W - 1; ++k) { float f[8]; unpack8(win[k], f);
#pragma unroll
        for (int e = 0; e < 8; ++e) sum[e] += f[e]; }
#pragma unroll
    for (int i = 0; i < R; ++i) {
        float cur[8], old[8]; unpack8(win[W - 1 + i], cur); unpack8(win[i], old);
        const int cnt = (s0 + i + 1) < W ? (s0 + i + 1) : W; const float inv = __builtin_amdgcn_rcpf((float)cnt);
        float o[8];
#pragma unroll
        for (int e = 0; e < 8; ++e) { sum[e] += cur[e]; o[e] = sum[e] * inv - cur[e]; sum[e] -= old[e]; }
        u32x4 w; w.x = pk2(o[0], o[1]); w.y = pk2(o[2], o[3]); w.z = pk2(o[4], o[5]); w.w = pk2(o[6], o[7]);
        *(u32x4*)(proj + (size_t)(r0 + i) * PC + PK + col) = w;
    }
}
__device__ __forceinline__ void pool_phase(const Frame& F, const ArgsV& args) {
    bf16_t* proj = (bf16_t*)(args.ws + WS_PROJ);
    const int gw = F.vcu * NWAVES + F.wave, NGW = F.G * NWAVES;
    for (int wt = gw; wt < (T / 32) * 4; wt += NGW) {
        const int rb = wt >> 2, g = wt & 3, r0 = rb * 32 + (F.lane >> 4) * 8, s0 = r0 & (SEQ - 1), col = g * 128 + (F.lane & 15) * 8;
        if (g == 0) pool_task<2>(proj, r0, s0, col); else if (g == 1) pool_task<4>(proj, r0, s0, col); else if (g == 2) pool_task<8>(proj, r0, s0, col); else pool_task<16>(proj, r0, s0, col);
    }
}
namespace pg8 {
struct BranchProb {
    static constexpr bool GATHER = false;
    const char* A; const char* Bt; unsigned ldb2; int G, c;
    __device__ __forceinline__ bool next(int i, Unit& u) const { const int L = (i / 3) * G + c; if (L >= 512) return false; tile_of(L, 128, 4, u.pm, u.pn); u.x0 = i % 3; u.x1 = 0; return true; }
    __device__ __forceinline__ const char* a_base(const Unit& u, int t) const { return A + (size_t)u.pm * 256 * (PC * 2) + (size_t)u.x0 * 1024 + (size_t)t * 128; }
    __device__ __forceinline__ unsigned a_off(const Unit&, int half, int R, int C) const { return (unsigned)(half * 128 + R) * (unsigned)(PC * 2) + (unsigned)C * 2u; }
    __device__ __forceinline__ const char* b_base(const Unit& u, int t) const { return Bt + (size_t)(u.x0 * 1024 + u.pn * 256) * 1024 + (size_t)t * 128; }
};
struct EpiBranch {
    static constexpr bool PERM = true, PROBE2 = false; static constexpr int ID = 3;
    bf16_t* proj; const float* ssq;
    __device__ __forceinline__ void operator()(const f32x4 (&acc)[2][2][4][2], const Unit& u, int wr, int wc, int fr, int fq) const {
        const int row0 = u.pm * BM + wr * 64 + fr, col0 = u.pn * BM + wc * 64 + 8 * fq, b = u.x0;
#pragma unroll
        for (int ai = 0; ai < 2; ++ai)
#pragma unroll
            for (int m = 0; m < 4; ++m) {
                const size_t row = (size_t)(row0 + ai * HALF + m * 16);
                float rs = 1.f;
                if (b == 2) { const f32x4 q0 = *(const f32x4*)(ssq + row * 8), q1 = *(const f32x4*)(ssq + row * 8 + 4); rs = __builtin_amdgcn_rsqf(((q0[0] + q0[1]) + (q0[2] + q0[3]) + (q1[0] + q1[1]) + (q1[2] + q1[3])) * (1.f / 512.f) + EPS); }
#pragma unroll
                for (int bj = 0; bj < 2; ++bj) {
                    const u32x4 gv = *(const u32x4*)(proj + row * PC + PG + b * 1024 + col0 + bj * 32);
                    bf16_t* mp = proj + row * PC + PU + col0 + bj * 32;
                    float v[8];
                    v[0] = acc[ai][bj][m][0][0] * rs * bf_lo(gv.x); v[1] = acc[ai][bj][m][0][1] * rs * bf_hi(gv.x); v[2] = acc[ai][bj][m][0][2] * rs * bf_lo(gv.y); v[3] = acc[ai][bj][m][0][3] * rs * bf_hi(gv.y);
                    v[4] = acc[ai][bj][m][1][0] * rs * bf_lo(gv.z); v[5] = acc[ai][bj][m][1][1] * rs * bf_hi(gv.z); v[6] = acc[ai][bj][m][1][2] * rs * bf_lo(gv.w); v[7] = acc[ai][bj][m][1][3] * rs * bf_hi(gv.w);
                    if (b > 0) {
                        const unsigned long long p0 = __hip_atomic_load((const unsigned long long*)mp, __ATOMIC_RELAXED, __HIP_MEMORY_SCOPE_AGENT);
                        const unsigned long long p1 = __hip_atomic_load((const unsigned long long*)mp + 1, __ATOMIC_RELAXED, __HIP_MEMORY_SCOPE_AGENT);
                        const unsigned a0 = (unsigned)p0, a1 = (unsigned)(p0 >> 32), a2 = (unsigned)p1, a3 = (unsigned)(p1 >> 32);
                        v[0] += bf_lo(a0); v[1] += bf_hi(a0); v[2] += bf_lo(a1); v[3] += bf_hi(a1); v[4] += bf_lo(a2); v[5] += bf_hi(a2); v[6] += bf_lo(a3); v[7] += bf_hi(a3);
                    }
                    u32x4 w; w.x = pk2(v[0], v[1]); w.y = pk2(v[2], v[3]); w.z = pk2(v[4], v[5]); w.w = pk2(v[6], v[7]);
                    *(u32x4*)mp = w;
                }
            }
    }
};

struct MoeTab { const volatile LAS int* tb; };
__device__ __forceinline__ void pair_of(int pid, int& lo, int& hi) { lo = pid < 3 ? 0 : (pid < 5 ? 1 : 2); hi = pid < 3 ? pid + 1 : (pid < 5 ? pid - 1 : 3); }
struct MoeGuProb {
    static constexpr bool GATHER = true;
    const char* H; const char* Wgu; const int* list; unsigned ldb2; const volatile LAS int* tb; int G, c;
    __device__ __forceinline__ bool next(int i, Unit& u) const {
        const int L = i * G + c, tile = L >> 3; if (tile >= tb[24]) return false;
        int li = 0;
#pragma unroll 1
        for (int j = 1; j < 24; ++j) li = (tile >= tb[j]) ? j : li;
        u.pm = tile; u.pn = L & 7; u.x0 = li; u.x1 = (tile - tb[li]) * 256; return true;
    }
    __device__ __forceinline__ const char* a_base(const Unit&, int t) const { return H + (size_t)t * 128; }
    __device__ __forceinline__ unsigned a_off(const Unit& u, int half, int R, int C) const {
        const int r = u.x1 + half * 128 + R; const int cnt = tb[32 + u.x0];
        const int tok = r < cnt ? list[(size_t)u.x0 * T + r] : 0;
        return (unsigned)tok * 2048u + (unsigned)C * 2u;
    }
    __device__ __forceinline__ const char* b_base(const Unit& u, int t) const {
        int lo, hi; pair_of(u.x0 % 6, lo, hi); const int e = (u.x0 / 6) * 4 + (u.pn < 4 ? lo : hi);
        return Wgu + (size_t)(e * 1024 + (u.pn & 3) * 256) * 2048 + (size_t)t * 128;
    }
};
struct EpiGateUp {
    static constexpr bool PERM = true, PROBE2 = false; static constexpr int ID = 4;
    bf16_t* amoe; const f32x2* lw;
    __device__ __forceinline__ void operator()(const f32x4 (&acc)[2][2][4][2], const Unit& u, int wr, int wc, int fr, int fq) const {
        const int rl0 = wr * 64 + fr, col0 = u.pn * 128 + wc * 32 + 8 * fq; const int which = u.pn >> 2;
#pragma unroll
        for (int ai = 0; ai < 2; ++ai)
#pragma unroll
            for (int m = 0; m < 4; ++m) {
                const int rl = rl0 + ai * HALF + m * 16;
                const f32x2 wv = lw[(size_t)u.x0 * T + u.x1 + rl]; const float cw = which ? wv.y : wv.x;
                const f32x4 g0 = acc[ai][0][m][0], g1 = acc[ai][0][m][1], u0 = acc[ai][1][m][0], u1 = acc[ai][1][m][1];
                u32x4 w;
                w.x = pk2(siluf_(g0[0]) * u0[0] * cw, siluf_(g0[1]) * u0[1] * cw); w.y = pk2(siluf_(g0[2]) * u0[2] * cw, siluf_(g0[3]) * u0[3] * cw);
                w.z = pk2(siluf_(g1[0]) * u1[0] * cw, siluf_(g1[1]) * u1[1] * cw); w.w = pk2(siluf_(g1[2]) * u1[2] * cw, siluf_(g1[3]) * u1[3] * cw);
                *(u32x4*)(amoe + (size_t)(u.pm * 256 + rl) * 1024 + col0) = w;
            }
    }
};
struct MoeDnProb {
    static constexpr bool GATHER = false;
    const char* A; const char* Wdn; unsigned ldb2; const volatile LAS int* tb; int G, c;
    __device__ __forceinline__ bool next(int i, Unit& u) const {
        const int L = i * G + c, tile = L >> 2; if (tile >= tb[24]) return false;
        int li = 0;
#pragma unroll 1
        for (int j = 1; j < 24; ++j) li = (tile >= tb[j]) ? j : li;
        u.pm = tile; u.pn = L & 3; u.x0 = li; u.x1 = (tile - tb[li]) * 256; return true;
    }
    __device__ __forceinline__ const char* a_base(const Unit& u, int t) const { return A + (size_t)u.pm * 256 * 2048 + (size_t)t * 128; }
    __device__ __forceinline__ unsigned a_off(const Unit&, int half, int R, int C) const { return (unsigned)(half * 128 + R) * 2048u + (unsigned)C * 2u; }
    __device__ __forceinline__ const char* b_base(const Unit& u, int t) const {
        int lo, hi; pair_of(u.x0 % 6, lo, hi); const int e = (u.x0 / 6) * 4 + (t < 8 ? lo : hi);
        return Wdn + (size_t)(e * 1024 + u.pn * 256) * 1024 + (size_t)(t & 7) * 128;
    }
};
struct EpiDown {
    static constexpr bool PERM = false, PROBE2 = false; static constexpr int ID = 5;
    float* x; const int* list; const volatile LAS int* tb;
    __device__ __forceinline__ void operator()(const f32x4 (&acc)[2][2][4][2], const Unit& u, int wr, int wc, int fr, int fq) const {
        const int rl0 = wr * 64 + fr, col0 = u.pn * BM + wc * 32 + 4 * fq; const int cnt = tb[32 + u.x0];
#pragma unroll
        for (int ai = 0; ai < 2; ++ai)
#pragma unroll
            for (int m = 0; m < 4; ++m) {
                const int r = u.x1 + rl0 + ai * HALF + m * 16;
                if (r < cnt) {
                    const int tok = list[(size_t)u.x0 * T + r]; float* xp = x + (size_t)tok * DM + col0;
#pragma unroll
                    for (int bj = 0; bj < 2; ++bj)
#pragma unroll
                        for (int n = 0; n < 2; ++n) { const f32x4 bs = *(const f32x4*)(xp + bj * HALF + n * 16); *(f32x4*)(xp + bj * HALF + n * 16) = bs + acc[ai][bj][m][n]; }
                }
            }
    }
};
}

__device__ __forceinline__ void moe_route(const Frame& F, const ArgsV& args, int l) {
    constexpr int OFF_W = 0, OFF_CNT = 81920, OFF_BASE = 82048, OFF_REC = 82176;
    LAS float* W = (LAS float*)(F.lds + OFF_W); volatile LAS int* lcnt = (volatile LAS int*)(F.lds + OFF_CNT); volatile LAS int* lbase = (volatile LAS int*)(F.lds + OFF_BASE);
    LAS int* rec = (LAS int*)(F.lds + OFF_REC);
    const float* wrg = args.in[27] + (size_t)l * DM * 4; const float* wre = args.in[29] + (size_t)l * DM * 16;
    const float* brg = args.in[28] + l * 4; const float* bre = args.in[30] + l * 16;
    float* x = args.out; bf16_t* H = (bf16_t*)(args.ws + WS_H);
    int* list = (int*)(args.ws + WS_LIST); f32x2* lw = (f32x2*)(args.ws + WS_LW);
    unsigned* gcnt = (unsigned*)(args.ws + WS_CTL) + CW_CNT + l * 32;
    for (int i = F.tid; i < DM * 4; i += NTHR) W[(i & 3) * DM + (i >> 2)] = wrg[i];
    for (int i = F.tid; i < DM * 16; i += NTHR) W[(4 + (i & 15)) * DM + (i >> 4)] = wre[i];
    f32x4 gv[4], hv[4]; load_gain(args.in[26] + (size_t)l * DM, F.lane, gv);
    const int rows_per_wg = T / F.G;
    for (int base = 0; base < rows_per_wg; base += 128) {
        if (F.tid < 24) lcnt[F.tid] = 0;
        __syncthreads();
        const int nrow = (rows_per_wg - base) < 128 ? (rows_per_wg - base) : 128;
        for (int rr = F.wave; rr < nrow; rr += NWAVES) {
            const int m = F.vcu * rows_per_wg + base + rr;
            { f32x4 xv[4]; load_row(x + (size_t)m * DM, F.lane, xv); norm_apply(xv, gv, H + (size_t)m * DM, F.lane, hv); }
            float lg[20];
#pragma unroll
            for (int cidx = 0; cidx < 20; ++cidx) {
                float s = 0.f;
#pragma unroll
                for (int j = 0; j < 4; ++j) { const f32x4 wv = *(const LAS f32x4*)(W + cidx * DM + 4 * F.lane + 256 * j); s += (hv[j].x * wv.x + hv[j].y * wv.y) + (hv[j].z * wv.z + hv[j].w * wv.w); }
                lg[cidx] = wave_sum(s);
            }
            if (F.lane == 0) {
                float gl[4]; float gm = -INFINITY; int gi = 0;
#pragma unroll
                for (int j = 0; j < 4; ++j) { gl[j] = lg[j] + brg[j]; if (gl[j] > gm) { gm = gl[j]; gi = j; } }
                float gs = 0.f;
#pragma unroll
                for (int j = 0; j < 4; ++j) gs += __expf(gl[j] - gm);
                const float g_p = 1.0f / gs;
                float el[4];
#pragma unroll
                for (int j = 0; j < 4; ++j) { float v = 0.f;
#pragma unroll
                    for (int q = 0; q < 4; ++q) v = (gi == q) ? lg[4 + q * 4 + j] + bre[q * 4 + j] : v;
                    el[j] = v; }
                int e0 = 0; float v0 = el[0];
#pragma unroll
                for (int j = 1; j < 4; ++j) if (el[j] > v0) { v0 = el[j]; e0 = j; }
                int e1 = -1; float v1 = -INFINITY;
#pragma unroll
                for (int j = 0; j < 4; ++j) if (j != e0 && el[j] > v1) { v1 = el[j]; e1 = j; }
                const float w1 = __expf(v1 - v0), inv = 1.0f / (1.0f + w1);
                const float c0 = g_p * inv, c1 = g_p * w1 * inv;
                const int lo = e0 < e1 ? e0 : e1, hi = e0 < e1 ? e1 : e0;
                const int pid = lo == 0 ? hi - 1 : (lo == 1 ? hi + 1 : 5);
                const int li = gi * 6 + pid;
                const int slot = __hip_atomic_fetch_add((LAS int*)&lcnt[li], 1, __ATOMIC_RELAXED, __HIP_MEMORY_SCOPE_WORKGROUP);
                rec[rr * 4 + 0] = li; rec[rr * 4 + 1] = slot; rec[rr * 4 + 2] = __float_as_int(e0 < e1 ? c0 : c1); rec[rr * 4 + 3] = __float_as_int(e0 < e1 ? c1 : c0);
            }
        }
        __syncthreads();
        if (F.tid < 24) { const int n = lcnt[F.tid]; lbase[F.tid] = n ? (int)atomicAdd(&gcnt[F.tid], (unsigned)n) : 0; }
        __syncthreads();
        if (F.tid < nrow) {
            const int li = rec[F.tid * 4 + 0], slot = lbase[li] + rec[F.tid * 4 + 1];
            const int m = F.vcu * rows_per_wg + base + F.tid;
            list[(size_t)li * T + slot] = m;
            lw[(size_t)li * T + slot] = (f32x2){__int_as_float(rec[F.tid * 4 + 2]), __int_as_float(rec[F.tid * 4 + 3])};
        }
        __syncthreads();
    }
}
__device__ __forceinline__ void moe_table(const Frame& F, const ArgsV& args, int l, volatile LAS int* tb) {
    const unsigned* gcnt = (const unsigned*)(args.ws + WS_CTL) + CW_CNT + l * 32;
    if (F.tid < 24) tb[32 + F.tid] = (int)__hip_atomic_load(gcnt + F.tid, __ATOMIC_RELAXED, __HIP_MEMORY_SCOPE_AGENT);
    __syncthreads();
    if (F.tid == 0) { int acc = 0; for (int j = 0; j < 24; ++j) { tb[j] = acc; acc += (tb[32 + j] + 255) >> 8; } tb[24] = acc; }
    __syncthreads();
}
__device__ __forceinline__ void final_norm_row(const float* xrow, float* orow, const float* g, int lane) {
    const f32x4* xr = (const f32x4*)xrow + lane; const f32x4* gr = (const f32x4*)g + lane;
    f32x4 v[4]; float s = 0.f;
#pragma unroll
    for (int j = 0; j < 4; ++j) { v[j] = xr[64 * j]; s += (v[j].x * v[j].x + v[j].y * v[j].y) + (v[j].z * v[j].z + v[j].w * v[j].w); }
    const float rstd = 1.0f / sqrtf(wave_sum(s) * (1.f / DM) + EPS);
#pragma unroll
    for (int j = 0; j < 4; ++j) { const f32x4 gg = gr[64 * j]; ((f32x4*)orow + lane)[64 * j] = v[j] * rstd * gg; }
}

constexpr int NPH = 14;
constexpr int NSTEPS = DEPTH * NPH + 1;
#ifndef EN_MIX
#define EN_MIX 1
#endif
#ifndef EN_XATTN
#define EN_XATTN 1
#endif
#ifndef EN_MOE
#define EN_MOE 1
#endif

__device__ __forceinline__ int launder(int v) { asm volatile("" : "+s"(v)); return v; }
__device__ __forceinline__ unsigned char* launder_p(unsigned char* p) { asm volatile("" : "+s"(p)); return p; }

__device__ __forceinline__ const AS4 unsigned char* launder_ka(const AS4 unsigned char* p) { asm volatile("" : "+s"(p)); return p; }

__global__ void __launch_bounds__(NTHR, 2) mega(Args kargs) {
    extern __shared__ __attribute__((aligned(16))) unsigned char lds_raw[];
    Frame F0;
    F0.lds = (LAS unsigned char*)lds_raw;
    F0.tid = threadIdx.x; F0.lane = F0.tid & 63; F0.wave = __builtin_amdgcn_readfirstlane(F0.tid >> 6);
    F0.G = gridDim.x; { const int bx = blockIdx.x; F0.vcu = (F0.G % 8 == 0) ? (bx % 8) * (F0.G / 8) + bx / 8 : bx; }
    volatile LAS unsigned* MISC = (volatile LAS unsigned*)(F0.lds + MISC_OFF);
    for (int u = F0.tid; u < (LDS_BYTES - MISC_OFF) / 4; u += NTHR) MISC[u] = 0u;
    __syncthreads();
    const int s_lo = kargs.s_lo, s_hi = kargs.s_hi;
    const bool use_bar = (s_hi - s_lo) > 1;
    XcdBarrier bar; bar.bar = (unsigned*)(kargs.ws + WS_CTL) + CW_BAR; bar.x = 0; bar.st = nullptr;
    if (use_bar) bar = xcd_barrier_post((unsigned*)(kargs.ws + WS_CTL) + CW_BAR, MISC + 8);
#ifndef ONLY_STEP
#define ONLY_STEP -1
#endif
#ifndef SKIP_STEP
#define SKIP_STEP -2
#endif
#ifndef STEP_MASK
#define STEP_MASK 0xffff
#endif
#define STEP_ON(p) ((ONLY_STEP < 0 || ONLY_STEP == (p)) && SKIP_STEP != (p) && ((STEP_MASK >> (p)) & 1))
#define IN(s) (launder(s_lo) <= (s) && (s) < launder(s_hi) && STEP_ON(((s) % NPH)))
#define SEAM(s) do { if (IN(s) && IN((s) + 1)) { xcd_barrier(bar); if (REPS(16) == 2) xcd_barrier(bar); } } while (0)
#ifndef REPEAT_STEP
#define REPEAT_STEP -1
#endif
#define REPS(p) ((REPEAT_STEP == (p)) ? 2 : 1)
#define PHASE_VARS Frame F = F0; F.wave = launder(F0.wave); F.lane = (int)__builtin_amdgcn_mbcnt_hi(~0u, __builtin_amdgcn_mbcnt_lo(~0u, 0u)); asm volatile("" : "+v"(F.lane)); F.tid = F.wave * 64 + F.lane; F.vcu = launder(F0.vcu); F.G = launder(F0.G); const int bid = launder((int)blockIdx.x); (void)bid; \
    const int l = launder(lraw); ArgsV args; args.in.ka = launder_ka((const AS4 unsigned char*)__builtin_amdgcn_kernarg_segment_ptr()); args.out = *(float* const AS4*)(args.in.ka + 280); args.ws = *(unsigned char* const AS4*)(args.in.ka + 288); unsigned char* ws = args.ws; unsigned char* wsw = ws + WS_W; float* out = args.out; \
    bf16_t* H = (bf16_t*)(ws + WS_H); bf16_t* MEMN = (bf16_t*)(ws + WS_MEMN); bf16_t* PROJ = (bf16_t*)(ws + WS_PROJ); \
    const float* xin = (l == 0) ? args.in[0] : out; (void)wsw; (void)H; (void)MEMN; (void)PROJ; (void)xin; (void)out

    for (int lraw = 0; lraw < DEPTH; ++lraw) {
        const int sb = lraw * NPH;
        if (IN(sb + 0)) {
            PHASE_VARS;
            const int gw = F.vcu * NWAVES + F.wave, NGW = F.G * NWAVES;
            for (int rep = 0; rep < REPS(0); ++rep) prep_weights(F, args, l);
            if (l == 0 && !EN_MIX) {
                for (int m = gw; m < T; m += NGW) { const f32x4* s = (const f32x4*)(args.in[0] + (size_t)m * DM) + F.lane; f32x4* d = (f32x4*)(out + (size_t)m * DM) + F.lane;
#pragma unroll
                    for (int j = 0; j < 4; ++j) d[64 * j] = s[64 * j]; }
            }
            for (int rep = 0; rep < REPS(15); ++rep) if (EN_MIX) norm_rows_dt(F, xin, args.in[20] + (size_t)l * DM, H, args.in[2] + (size_t)l * DM * IN_COLS, (float*)(ws + WS_DT));
            if (EN_XATTN) norm_rows_plain(F, args.in[1], args.in[22] + (size_t)l * DM, MEMN, BATCH * NMEM);
        }
        SEAM(sb + 0);
        if (IN(sb + 1)) {
            PHASE_VARS;
#ifndef PROBE_INPROJ
#define PROBE_INPROJ 0
#endif
            for (int rep = 0; rep < (PROBE_INPROJ ? 2 : REPS(1)); ++rep) if (EN_MIX) {
                const bool dm = PROBE_INPROJ && rep == 0;
                pg8::PlainProb P{(const char*)H, (const char*)(wsw + W_IN), 2048u, 2048u, 128, 25, F.G, bid, (dm && (PROBE_INPROJ & 2)) ? 0 : 1, (dm && (PROBE_INPROJ & 4)) ? 0 : 1};
                pg8::EpiStore E{dm ? (bf16_t*)(ws + WS_STATES) : PROJ, dm ? 0 : PC, 13, args.in[3] + (size_t)l * 3072, PG};
#ifndef STAGGER_TICKS
#define STAGGER_TICKS 0
#endif
                if (STAGGER_TICKS > 0 && !dm) {
                    const unsigned long long t0 = __builtin_amdgcn_s_memrealtime(), dl = (unsigned long long)(((bid >> 3) & 7) * STAGGER_TICKS);
                    while (__builtin_amdgcn_s_memrealtime() - t0 < dl) __builtin_amdgcn_s_sleep(8);
                }
                pg8::gemm_phase<pg8::EpiStore, pg8::PlainProb, true>(F.lds, F.tid, P, E, 16);
            }
            if (EN_XATTN) {
                pg8::PlainProb P{(const char*)MEMN, (const char*)(wsw + W_XKV), 2048u, 2048u, 16, 2, F.G, bid};
                pg8::EpiStore E{(bf16_t*)(ws + WS_KV), 512, 1 << 30, nullptr, 0};
                pg8::gemm_phase<pg8::EpiStore, pg8::PlainProb, true>(F.lds, F.tid, P, E, 16);
            }
        }
        SEAM(sb + 1);
        if (IN(sb + 2) && EN_MIX) { PHASE_VARS; for (int it = F.vcu; it < 512 * REPS(2); it += F.G) ssd_local(F, args, l, it & 511); }
        SEAM(sb + 2);
        if (IN(sb + 3) && EN_MIX) {
            PHASE_VARS;
            ssd_scan(F, args);
            const float lam_init = 0.8f - 0.6f * __expf(-0.3f * (float)l);
            float lam;
            { float s1 = 0.f, s2 = 0.f; for (int i = 0; i < 64; ++i) { s1 += args.in[4][l * 64 + i] * args.in[5][l * 64 + i]; s2 += args.in[6][l * 64 + i] * args.in[7][l * 64 + i]; }
              lam = __expf(s1) - __expf(s2) + lam_init; }
            for (int it = F.vcu; it < 256; it += F.G) {
                const int bh = it >> 2, b = bh >> 2, h = bh & 3, sidx = it & 3;
                LAS float* btab = (LAS float*)(F.lds + attn_off_bt<2, 128, true>());
                if (F.tid < 256) btab[F.tid] = args.in[9][rel_bucket(F.tid - 192) * 4 + h] * LOG2E;
                __syncthreads();
                for (int rep = 0; rep < REPS(3); ++rep)
                for (int k = 0; k < 2; ++k) {
                    const int qb = k ? 7 - sidx : sidx, q0 = qb * 256;
                    const bf16_t* base = PROJ + (size_t)(b * SEQ) * PC;
                    const bool dummy = (REPS(3) == 2) && rep == 0;
                    attn_unit<2, 128, true>(F.lds, F.tid, base + (size_t)q0 * PC + PQ + h * 128, PC, base + PK + h * 128, base + PV + h * 128, PC,
                                            dummy ? H + (size_t)F.vcu * 1024 : PROJ + (size_t)(b * SEQ + q0) * PC + PQ + h * 128, dummy ? 0 : PC, q0 / 64 + 4, q0, lam, args.in[8] + (size_t)l * 128, 1.0f - lam_init);
                }
            }
        }
        SEAM(sb + 3);
        if (IN(sb + 4) && EN_MIX) {
            PHASE_VARS;
            for (int it = F.vcu; it < 512 * REPS(4); it += F.G) ssd_out(F, args, l, it & 511);
            for (int rep = 0; rep < REPS(14); ++rep) pool_phase(F, args);
        }
        SEAM(sb + 4);
        if (IN(sb + 5) && EN_MIX) {
            PHASE_VARS;
            pg8::BranchProb P{(const char*)PROJ, (const char*)(wsw + W_BR), 1024u, F.G, bid};
            pg8::EpiBranch E{PROJ, (const float*)(ws + WS_SSQ)};
            for (int rep = 0; rep < REPS(5); ++rep) pg8::gemm_phase<pg8::EpiBranch, pg8::BranchProb, true>(F.lds, F.tid, P, E, 8);
        }
        SEAM(sb + 5);
        if (IN(sb + 6) && EN_MIX) {
            PHASE_VARS;
            pg8::PlainProb P{(const char*)(PROJ + PU), (const char*)(wsw + W_MIX), (unsigned)(PC * 2), 2048u, 128, 4, F.G, bid};
            pg8::EpiResid E{xin, out, DM};
            pg8::gemm_phase<pg8::EpiResid, pg8::PlainProb, true>(F.lds, F.tid, P, E, 16);
        }
        SEAM(sb + 6);
        if (IN(sb + 7) && EN_XATTN) { PHASE_VARS; for (int rep = 0; rep < REPS(7); ++rep) norm_rows_plain(F, out, args.in[21] + (size_t)l * DM, H, T); }
        SEAM(sb + 7);
        if (IN(sb + 8) && EN_XATTN) {
            PHASE_VARS;
            pg8::PlainProb P{(const char*)H, (const char*)(wsw + W_XQ), 2048u, 2048u, 128, 1, F.G, bid};
            pg8::EpiStore E{(bf16_t*)(ws + WS_XQ), 256, 1 << 30, nullptr, 0};
            pg8::gemm_phase<pg8::EpiStore, pg8::PlainProb, true>(F.lds, F.tid, P, E, 16);
        }
        SEAM(sb + 8);
        if (IN(sb + 9) && EN_XATTN) {
            PHASE_VARS;
            for (int rep = 0; rep < REPS(9); ++rep)
            for (int it = F.vcu; it < 512; it += F.G) {
                const int b = it >> 5, h = (it >> 3) & 3, qb = it & 7;
                const bf16_t* XQ = (const bf16_t*)(ws + WS_XQ); bf16_t* XO = (bf16_t*)(ws + WS_XO); const bf16_t* KV = (const bf16_t*)(ws + WS_KV);
                attn_unit<1, 64, false>(F.lds, F.tid, XQ + (size_t)(b * SEQ + qb * 256) * 256 + h * 64, 256, KV + (size_t)(b * NMEM) * 512 + h * 64, KV + (size_t)(b * NMEM) * 512 + 256 + h * 64, 512,
                                        XO + (size_t)(b * SEQ + qb * 256) * 256 + h * 64, 256, 4, 0, 0.f, nullptr, 1.f);
            }
        }
        SEAM(sb + 9);
        if (IN(sb + 10) && EN_XATTN) {
            PHASE_VARS;
            pg8::PlainProb P{(const char*)(ws + WS_XO), (const char*)(wsw + W_XO), 512u, 512u, 128, 4, F.G, bid};
            pg8::EpiResid E{out, out, DM};
            pg8::gemm_phase<pg8::EpiResid, pg8::PlainProb, true>(F.lds, F.tid, P, E, 4);
        }
        SEAM(sb + 10);
        if (IN(sb + 11) && EN_MOE) { PHASE_VARS; moe_route(F, args, l); }
        SEAM(sb + 11);
        if (IN(sb + 12) && EN_MOE) {
            PHASE_VARS;
            volatile LAS int* mtab = (volatile LAS int*)(F.lds + MISC_OFF + 256);
            moe_table(F, args, l, mtab);
            pg8::MoeGuProb P{(const char*)H, (const char*)(wsw + W_GU), (const int*)(ws + WS_LIST), 2048u, mtab, F.G, bid};
            pg8::EpiGateUp E{(bf16_t*)(ws + WS_AMOE), (const f32x2*)(ws + WS_LW)};
            for (int rep = 0; rep < REPS(12); ++rep) pg8::gemm_phase<pg8::EpiGateUp, pg8::MoeGuProb, true>(F.lds, F.tid, P, E, 16);
        }
        SEAM(sb + 12);
        if (IN(sb + 13) && EN_MOE) {
            PHASE_VARS;
            volatile LAS int* mtab = (volatile LAS int*)(F.lds + MISC_OFF + 256);
            moe_table(F, args, l, mtab);
            pg8::MoeDnProb P{(const char*)(ws + WS_AMOE), (const char*)(wsw + W_DN), 1024u, mtab, F.G, bid};
            pg8::EpiDown E{out, (const int*)(ws + WS_LIST), mtab};
            pg8::gemm_phase<pg8::EpiDown, pg8::MoeDnProb, true>(F.lds, F.tid, P, E, 16);
        }
        SEAM(sb + 13);
    }
    if (IN(DEPTH * NPH)) {
        const int gw = F0.vcu * NWAVES + F0.wave, NGW = F0.G * NWAVES; float* out = kargs.out;
        const int lane_f = (int)__builtin_amdgcn_mbcnt_hi(~0u, __builtin_amdgcn_mbcnt_lo(~0u, 0u));
        for (int m = gw; m < T; m += NGW) final_norm_row(out + (size_t)m * DM, out + (size_t)m * DM, kargs.in[34], lane_f);
    }
#undef IN
#undef SEAM
}

extern "C" void kernel_launch(void* const* d_in, const int* in_sizes, int n_in, void* d_out, int out_size, void* d_ws, size_t ws_size, hipStream_t stream) {
    static int grid = 0;
    if (grid == 0) {
        if (n_in != 35 || out_size != T * DM || ws_size < WS_END) { fprintf(stderr, "kernel_launch: unexpected sizes n_in %d out %d ws %zu (need %zu)\n", n_in, out_size, ws_size, (size_t)WS_END); grid = -1; return; }
        int dev = 0, cus = 0, per_cu = 0;
        if (hipGetDevice(&dev) != hipSuccess || hipDeviceGetAttribute(&cus, hipDeviceAttributeMultiprocessorCount, dev) != hipSuccess) { grid = -1; return; }
        if (hipFuncSetAttribute((const void*)mega, hipFuncAttributeMaxDynamicSharedMemorySize, LDS_BYTES) != hipSuccess) { fprintf(stderr, "kernel_launch: hipFuncSetAttribute failed\n"); grid = -1; return; }
        if (hipOccupancyMaxActiveBlocksPerMultiprocessor(&per_cu, (const void*)mega, NTHR, LDS_BYTES) != hipSuccess || per_cu < 1) fprintf(stderr, "kernel_launch: occupancy query says %d\n", per_cu);
        (void)hipGetLastError();
        if (cus < 256) { fprintf(stderr, "kernel_launch: built for a 256-CU device, found %d CUs\n", cus); grid = -1; return; }
        grid = 256;
    }
    if (grid < 0) return;
    (void)hipMemsetAsync((char*)d_ws + WS_CTL, 0, CTL_BYTES, stream);
    Args a; memset(&a, 0, sizeof(a));
    for (int i = 0; i < 35; ++i) a.in[i] = (const float*)d_in[i];
    a.out = (float*)d_out; a.ws = (unsigned char*)d_ws;
#ifndef ONE_LAUNCH
#define ONE_LAUNCH 1
#endif
#if ONE_LAUNCH
    a.s_lo = 0; a.s_hi = NSTEPS;
    hipLaunchKernelGGL(mega, dim3(grid), dim3(NTHR), LDS_BYTES, stream, a);
#else
    for (int s = 0; s < NSTEPS; ++s) { a.s_lo = s; a.s_hi = s + 1; hipLaunchKernelGGL(mega, dim3(grid), dim3(NTHR), LDS_BYTES, stream, a); }
#endif
}
```

```cpp
#define NT_STORES 1
#define GATE_LOGIT 1
#define MERGE1011 0
#define MOE_FOLD 1
#include <hip/hip_runtime.h>
#include <cstdio>
#include <cstdint>
#include <cstring>

#define LAS __attribute__((address_space(3)))
#define GAS __attribute__((address_space(1)))
typedef unsigned short bf16_t;
typedef short bf16x8 __attribute__((ext_vector_type(8)));
typedef short s16x4 __attribute__((ext_vector_type(4)));
typedef float f32x2 __attribute__((ext_vector_type(2)));
typedef float f32x4 __attribute__((ext_vector_type(4)));
typedef float f32x16 __attribute__((ext_vector_type(16)));
typedef unsigned u32x2 __attribute__((ext_vector_type(2)));
typedef unsigned u32x4 __attribute__((ext_vector_type(4)));

constexpr int DM = 1024, BATCH = 16, SEQ = 2048, T = BATCH * SEQ, DEPTH = 4, NMEM = 256;
constexpr int IN_COLS = 6408, COL_DT = 3328, COL_GATE = 3336;
constexpr int PC = 3328;
constexpr int PQ = 0, PK = 512, PV = 1024, PU = 1536, PZ = 2048, PX = 2560, PG = 3328;
constexpr float EPS = 1e-6f;
constexpr float LOG2E = 1.4426950408889634f;
constexpr int NWAVES = 8, NTHR = 512;

constexpr size_t MiB = 1u << 20;
constexpr size_t WS_CTL = 0, CTL_BYTES = 1 * MiB;
constexpr size_t WS_W = 1 * MiB;
constexpr size_t W_IN = 0;
constexpr size_t W_XKV = W_IN + (size_t)6400 * 1024 * 2;
constexpr size_t W_BR = W_XKV + (size_t)512 * 1024 * 2;
constexpr size_t W_MIX = W_BR + (size_t)3 * 1024 * 512 * 2;
constexpr size_t W_XQ = W_MIX + (size_t)1024 * 1024 * 2;
constexpr size_t W_XO = W_XQ + (size_t)256 * 1024 * 2;
constexpr size_t W_GU = W_XO + (size_t)1024 * 256 * 2;
constexpr size_t W_DN = W_GU + (size_t)16 * 1024 * 1024 * 2;
constexpr size_t W_END = W_DN + (size_t)16 * 1024 * 512 * 2;
constexpr size_t WS_H = WS_W + 68 * MiB;
constexpr size_t WS_MEMN = WS_H + (size_t)T * DM * 2;
constexpr size_t WS_PROJ = WS_MEMN + (size_t)4096 * DM * 2;
constexpr size_t WS_GATE = WS_PROJ + (size_t)T * PC * 2;
constexpr size_t WS_STATES = WS_GATE + (size_t)T * 3072 * 2;
constexpr size_t WS_SSQ2 = WS_STATES + (size_t)32 * MiB;
constexpr size_t WS_LRS = WS_SSQ2 + (size_t)2 * MiB;
constexpr size_t WS_DT = WS_STATES + (size_t)64 * MiB;
constexpr size_t WS_SSQ = WS_DT + 1 * MiB;
constexpr size_t WS_DEC = WS_SSQ + 1 * MiB;
constexpr size_t WS_KV = WS_DEC + 1 * MiB;
constexpr size_t WS_LIST = WS_KV + 4 * MiB;
constexpr size_t WS_LW = WS_LIST + (size_t)24 * T * 4;
constexpr size_t WS_XB = WS_LW + (size_t)24 * T * 8;
constexpr size_t WS_END = WS_XB + (size_t)T * DM * 2;
static_assert(W_END <= 68 * MiB, "weights region");
constexpr size_t WS_XQ = WS_PROJ;
constexpr size_t WS_XO = WS_PROJ + 16 * MiB;
constexpr size_t WS_AMOE = WS_PROJ;

constexpr int CW_BAR = 1024;
constexpr int CW_CNT = 8192;
constexpr int CW_PAN = 81920;
constexpr int CW_F8 = 65536;
constexpr int CW_TILE = 16384;

constexpr int RING_BYTES = 155648;
constexpr int MISC_OFF = RING_BYTES;
constexpr int LDS_BYTES = 163840;

__device__ __forceinline__ unsigned f2bf(float f) { unsigned u = __builtin_bit_cast(unsigned, f); return (u + 0x7fffu + ((u >> 16) & 1u)) >> 16; }
__device__ __forceinline__ unsigned pk2(float lo, float hi) { typedef __bf16 bf2 __attribute__((ext_vector_type(2))); f32x2 v = {lo, hi}; bf2 b = __builtin_convertvector(v, bf2); return __builtin_bit_cast(unsigned, b); }
__device__ __forceinline__ float bf_lo(unsigned w) { return __builtin_bit_cast(float, w << 16); }
__device__ __forceinline__ float bf_hi(unsigned w) { return __builtin_bit_cast(float, w & 0xffff0000u); }
__device__ __forceinline__ float bf2f(bf16_t b) { return __builtin_bit_cast(float, ((unsigned)b) << 16); }
__device__ __forceinline__ float wave_sum(float v) {
#pragma unroll
    for (int o = 1; o < 64; o <<= 1) v += __shfl_xor(v, o);
    return v;
}
__device__ __forceinline__ float sigmoidf_(float x) { return __builtin_amdgcn_rcpf(1.0f + __builtin_amdgcn_exp2f(x * -1.4426950408889634f)); }
__device__ __forceinline__ float siluf_(float x) { return x * __builtin_amdgcn_rcpf(1.0f + __builtin_amdgcn_exp2f(x * -1.4426950408889634f)); }
__device__ __forceinline__ float zero_v() { float z = 0.f; asm volatile("" : "+v"(z)); return z; }
#define LDS_WAIT() asm volatile("s_waitcnt lgkmcnt(0)" ::: "memory")
#define VM_WAIT() asm volatile("s_waitcnt vmcnt(0)" ::: "memory")

#define XB_TMO      128
#define XB_XCNT(j)  (256  + 64 * (j))
#define XB_XSUB(j)  (1280 + 64 * (j))
#define XB_XGEN(j)  (2304 + 64 * (j))
#define XB_TOP      3328
#define XB_TOPGEN   3392
#define XCD_BAR_WORDS 3456
#define XB_SPIN_CAP (1u << 18)
__device__ __forceinline__ unsigned xb_ld(unsigned* p)              { return __hip_atomic_load(p, __ATOMIC_RELAXED, __HIP_MEMORY_SCOPE_AGENT); }
__device__ __forceinline__ unsigned xb_add(unsigned* p, unsigned v) { return __hip_atomic_fetch_add(p, v, __ATOMIC_RELAXED, __HIP_MEMORY_SCOPE_AGENT); }
__device__ __forceinline__ unsigned xb_xcc_id() { return (unsigned)__builtin_amdgcn_s_getreg((3 << 11) | 20) & 0xFu; }
#define XB_SPIN(cond, bar) do { unsigned _sp = 0; while (cond) { __builtin_amdgcn_s_sleep(1); \
    if ((++_sp & 255u) == 0u) { if (xb_ld(&(bar)[XB_TMO])) break; if (_sp > XB_SPIN_CAP) { atomicAdd(&(bar)[XB_TMO], 1u); break; } } } } while (0)
struct XcdBarrier { unsigned* bar; unsigned x; volatile LAS unsigned* st; };
__device__ __forceinline__ XcdBarrier xcd_barrier_post(unsigned* bar, volatile LAS unsigned* st) {
    XcdBarrier b; b.bar = bar; b.x = xb_xcc_id(); b.st = st;
    if (threadIdx.x == 0) (void)xb_add(&bar[XB_XCNT(b.x)], 1u);
    return b;
}
__device__ __forceinline__ void xcd_barrier_complete(unsigned* bar, unsigned x, unsigned& nloc, unsigned& nx) {
    const unsigned G = gridDim.x * gridDim.y * gridDim.z;
    unsigned sum, cnt, mine, sp = 0u;
    for (;;) {
        sum = 0u; cnt = 0u; mine = 0u;
#pragma unroll
        for (unsigned j = 0; j < 16; ++j) { const unsigned c = xb_ld(&bar[XB_XCNT(j)]); sum += c; cnt += (c > 0u) ? 1u : 0u; mine = (j == x) ? c : mine; }
        if (sum == G) break;
        __builtin_amdgcn_s_sleep(1);
        if ((++sp & 255u) == 0u) { if (xb_ld(&bar[XB_TMO])) break; if (sp > XB_SPIN_CAP) { atomicAdd(&bar[XB_TMO], 1u); break; } }
    }
    nloc = mine > 0u ? mine : 1u; nx = cnt > 0u ? cnt : 1u;
}
__device__ __forceinline__ void xcd_barrier(const XcdBarrier& b, const int wave_id) {
    asm volatile("s_waitcnt vmcnt(0)" ::: "memory");
    __syncthreads();
    unsigned ones_ = ~0u; asm volatile("" : "+s"(ones_));
    if (wave_id == 0 && __builtin_amdgcn_mbcnt_hi(ones_, __builtin_amdgcn_mbcnt_lo(ones_, 0u)) == 0u) {
        unsigned* bar = b.bar; asm volatile("" : "+s"(bar));
        __builtin_amdgcn_s_waitcnt(0);
        unsigned nloc = b.st[0], nx = b.st[1];
        if (nloc == 0u) { xcd_barrier_complete(bar, b.x, nloc, nx); b.st[0] = nloc; b.st[1] = nx; }
        const unsigned old = xb_add(&bar[XB_XSUB(b.x)], 1u);
        const unsigned gen = old / nloc;
        if (old + 1u == (gen + 1u) * nloc) {
            __builtin_amdgcn_fence(__ATOMIC_RELEASE, "agent");
            asm volatile("s_waitcnt vmcnt(0)" ::: "memory");
            const unsigned og = xb_add(&bar[XB_TOP], 1u);
            const unsigned tg = og / nx;
            if (og + 1u == (tg + 1u) * nx) xb_add(&bar[XB_TOPGEN], 1u);
            else XB_SPIN(xb_ld(&bar[XB_TOPGEN]) == tg, bar);
            __builtin_amdgcn_fence(__ATOMIC_ACQUIRE, "agent");
            xb_add(&bar[XB_XGEN(b.x)], 1u);
            asm volatile("s_waitcnt vmcnt(0)" ::: "memory");
        } else {
            XB_SPIN(xb_ld(&bar[XB_XGEN(b.x)]) == gen, bar);
            __builtin_amdgcn_fence(__ATOMIC_ACQUIRE, "agent");
            asm volatile("s_waitcnt vmcnt(0)" ::: "memory");
        }
    }
    __syncthreads();
}


__device__ __forceinline__ unsigned* pan_ctr(unsigned char* ws, int l, int kind, int pm) { return (unsigned*)(ws + WS_CTL) + CW_PAN + ((l * 4 + kind) * 128 + pm) * 16; }
__device__ __forceinline__ void pan_arrive(unsigned* ctr, int lane) { VM_WAIT(); if (lane == 0) __hip_atomic_fetch_add(ctr, 1u, __ATOMIC_RELAXED, __HIP_MEMORY_SCOPE_AGENT); }
__device__ __forceinline__ void pan_wait(const unsigned* ctr, unsigned need, int tid, unsigned* tmo) {
    if (tid < 64) {
        unsigned polls = 0;
        while ((unsigned)__builtin_amdgcn_readfirstlane(__hip_atomic_load(ctr, __ATOMIC_RELAXED, __HIP_MEMORY_SCOPE_AGENT)) < need) {
            if (++polls > (1u << 22)) { if (tid == 0) __hip_atomic_store(tmo, 1u, __ATOMIC_RELAXED, __HIP_MEMORY_SCOPE_AGENT); break; }
            __builtin_amdgcn_s_sleep(2);
        }
        __builtin_amdgcn_fence(__ATOMIC_ACQUIRE, "agent");
        VM_WAIT();
    }
    asm volatile("" ::: "memory"); __builtin_amdgcn_s_barrier(); asm volatile("" ::: "memory");
}
namespace pg8 {
constexpr int BM = 256, BK = 64, HALF = 128, HTB = HALF * BK * 2, STAGE_BYTES = 8 * HTB, NXCD = 8, WGM = 8;
__device__ __forceinline__ int lds_byte(int r, int c) { const int st = (r >> 4) * 2 + (c >> 5), rr = r & 15, cc = c & 31, ob = rr * 64 + cc * 2; return st * 1024 + (ob ^ (((ob >> 9) & 1) << 5)); }
__device__ __forceinline__ void stage_rc(int b, int& R, int& C) { const int st = b / 1024, sb = b % 1024, swz = sb ^ (((sb >> 9) & 1) << 5); R = (st >> 1) * 16 + swz / 64; C = (st & 1) * 32 + (swz % 64) / 2; }
__device__ __forceinline__ int perm32(int rho) { const int n = rho >> 4, i = rho & 15; return 8 * (i >> 2) + 4 * n + (i & 3); }
struct Unit { int pm, pn, x0, x1, x2 = 0; };
__device__ __forceinline__ void tile_of(int L, int nM, int nN, int& pm, int& pn) {
    const int nwg = nM * nN; int wgid = L; { const int q = nwg / NXCD, r = nwg % NXCD, xcd = wgid % NXCD, off = wgid / NXCD; wgid = (xcd < r ? xcd * (q + 1) : r * (q + 1) + (xcd - r) * q) + off; }
    const int nig = WGM * nN, gid = wgid / nig, fm = gid * WGM, gsz = (nM - fm) < WGM ? (nM - fm) : WGM;
    pm = fm + ((wgid % nig) % gsz); pn = (wgid % nig) / gsz;
}
struct PlainProb {
    static constexpr bool GATHER = false;
    const char* A; const char* Bt; unsigned lda2, ldb2; int nM, nN, G, c; int am = 1, bm = 1; int lim = 0;
    const unsigned* wctr = nullptr; unsigned need = 0; unsigned* dctr = nullptr; unsigned* tmo = nullptr;
    __device__ __forceinline__ bool next(int i, Unit& u) const { const long L = (long)i * G + c; if (L >= (lim ? (long)lim : (long)nM * nN)) return false; tile_of((int)L, nM, nN, u.pm, u.pn); u.x0 = 0; u.x1 = 0; return true; }
    __device__ __forceinline__ const char* a_base(const Unit& u, int t) const { return A + (size_t)(u.pm * am) * 256 * lda2 + (size_t)t * 128; }
    __device__ __forceinline__ unsigned a_off(const Unit&, int half, int R, int C) const { return (unsigned)(half * 128 + R) * lda2 + (unsigned)C * 2u; }
    __device__ __forceinline__ const char* b_base(const Unit& u, int t) const { return Bt + (size_t)(u.pn * bm) * 256 * ldb2 + (size_t)t * 128; }
    __device__ __forceinline__ void a_ready(const Unit& u, int tid) const { if (wctr) pan_wait(wctr + 16 * u.pm, need, tid, tmo); }
    __device__ __forceinline__ void done(const Unit& u, int lane) const { if (dctr) pan_arrive(dctr + 16 * u.pm, lane); }
};

struct HalfTailProb {
    static constexpr bool GATHER = false;
    const char* A; const char* Bt; unsigned lda2, ldb2; int nM, nN, first, nhalf, G, c;
    __device__ __forceinline__ bool next(int i, Unit& u) const { const int h = i * G + c; if (h >= nhalf) return false; tile_of(first + (h >> 1), nM, nN, u.pm, u.pn); u.x0 = h & 1; u.x1 = 0; return true; }
    __device__ __forceinline__ const char* a_base(const Unit& u, int t) const { return A + (size_t)u.pm * 256 * lda2 + (size_t)t * 128; }
    __device__ __forceinline__ unsigned a_off(const Unit&, int half, int R, int C) const { return (unsigned)(half * 128 + R) * lda2 + (unsigned)C * 2u; }
    __device__ __forceinline__ const char* b_base(const Unit& u, int t) const { return Bt + (size_t)(u.pn * 256 + u.x0 * 128) * ldb2 + (size_t)t * 128; }
    __device__ __forceinline__ void a_ready(const Unit&, int) const {}
    __device__ __forceinline__ void done(const Unit&, int) const {}
};

typedef float f32x4_ __attribute__((ext_vector_type(4)));
template <class Epi, class Prob, bool ALIGN_EPI, int NB = 2>
__device__ __forceinline__ void gemm_phase(LAS unsigned char* lds, const int tid, const Prob& P, const Epi& E, const int nt) {
    const int wid = __builtin_amdgcn_readfirstlane(tid >> 6), lane = tid & 63, wr = wid >> 2, wc = wid & 3, fr = lane & 15, fq = lane >> 4;
    int Rs[2], Cs[2]; unsigned voffB[2];
#pragma unroll
    for (int i = 0; i < 2; ++i) { stage_rc(tid * 16 + i * 8192, Rs[i], Cs[i]); const int Rb = Epi::PERM ? ((NB == 2 ? 64 : 32) * (Rs[i] >> 5) + perm32(Rs[i] & 31)) : Rs[i]; voffB[i] = (unsigned)Rb * P.ldb2 + (unsigned)Cs[i] * 2u; }
    const unsigned hstepB = (Epi::PERM ? 32u : 128u) * P.ldb2;
    const unsigned ldsw = (unsigned)wid * 1024u;
    const int aoff = lds_byte(wr * 64 + fr, fq * 8), boff = lds_byte(wc * 32 + fr, fq * 8);
#define PG8_SA(b, h) (((b) * 2 + (h)) * HTB)
#define PG8_SB(b, h) ((4 + (b) * 2 + (h)) * HTB)
#define PG8_STAGE(bufoff, gbase, voff) do { _Pragma("unroll") for (int _i = 0; _i < 2; ++_i) \
        __builtin_amdgcn_global_load_lds((const unsigned*)((const char*)(gbase) + (voff)[_i]), (LAS unsigned*)(lds + (bufoff) + ldsw + _i * 8192), 16, 0, 0); } while (0)
#define PG8_LDA(dst, b, h) do { _Pragma("unroll") for (int m = 0; m < 4; ++m) _Pragma("unroll") for (int k = 0; k < 2; ++k) dst[m][k] = *(const LAS bf16x8*)(lds + PG8_SA(b, h) + aoff + m * 2048 + k * 1024); } while (0)
#define PG8_LDB(dst, b, h) do { _Pragma("unroll") for (int n = 0; n < 2; ++n) _Pragma("unroll") for (int k = 0; k < 2; ++k) dst[n][k] = *(const LAS bf16x8*)(lds + PG8_SB(b, h) + boff + n * 2048 + k * 1024); } while (0)
#define PG8_MMA(ai, bj, At, Bt) do { __builtin_amdgcn_s_setprio(1); _Pragma("unroll") for (int m = 0; m < 4; ++m) _Pragma("unroll") for (int n = 0; n < 2; ++n) _Pragma("unroll") for (int k = 0; k < 2; ++k) \
        acc[ai][bj][m][n] = __builtin_amdgcn_mfma_f32_16x16x32_bf16(Bt[n][k], At[m][k], acc[ai][bj][m][n], 0, 0, 0); __builtin_amdgcn_s_setprio(0); } while (0)
#define PG8_WAIT_V(n) asm volatile("s_waitcnt vmcnt(" #n ")" ::: "memory")
#define PG8_WAIT_L(n) asm volatile("s_waitcnt lgkmcnt(" #n ")" ::: "memory")
#define PG8_WAIT_LOOP do { if constexpr (NB == 2) PG8_WAIT_V(8); else PG8_WAIT_V(6); } while (0)
#define PG8_BAR __builtin_amdgcn_s_barrier()
#define PG8_SCHED __builtin_amdgcn_sched_barrier(0)
    Unit cur, nxt; int ui = 0;
#ifdef PROBE_DUP
    constexpr bool DUP = (Epi::ID == PROBE_DUP);
#else
    constexpr bool DUP = false;
#endif
    if (!P.next(0, cur)) return;
    static_assert(NB == 2 || Epi::PERM, "the half-width tile is written for the permuted column order");
    f32x4 acc[2][NB][4][2];
#pragma unroll
    for (int a = 0; a < 2; ++a)
#pragma unroll
        for (int b = 0; b < NB; ++b)
#pragma unroll
            for (int m = 0; m < 4; ++m)
#pragma unroll
                for (int n = 0; n < 2; ++n) acc[a][b][m][n] = (f32x4){0.f, 0.f, 0.f, 0.f};
    bf16x8 At[4][2], B0[2][2], B1[2][2];
    P.a_ready(cur, tid);
    unsigned cA0[2], cA1[2], nA0[2], nA1[2];
#pragma unroll
    for (int i = 0; i < 2; ++i) { cA0[i] = P.a_off(cur, 0, Rs[i], Cs[i]); cA1[i] = P.a_off(cur, 1, Rs[i], Cs[i]); nA0[i] = cA0[i]; nA1[i] = cA1[i]; }
    { const char* a0 = P.a_base(cur, 0); const char* b0 = P.b_base(cur, 0); const char* a1p = P.a_base(cur, 1); const char* b1p = P.b_base(cur, 1);
      PG8_STAGE(PG8_SB(0, 0), b0, voffB); if constexpr (NB == 2) PG8_STAGE(PG8_SB(0, 1), b0 + hstepB, voffB); PG8_STAGE(PG8_SA(0, 0), a0, cA0); PG8_STAGE(PG8_SA(0, 1), a0, cA1);
      if (wr == 1) PG8_BAR;
      PG8_WAIT_V(2); PG8_BAR;
      PG8_STAGE(PG8_SB(1, 0), b1p, voffB); PG8_STAGE(PG8_SA(1, 0), a1p, cA0); if constexpr (NB == 2) PG8_STAGE(PG8_SB(1, 1), b1p + hstepB, voffB);
      if constexpr (NB == 2) PG8_WAIT_V(6); else PG8_WAIT_V(4);
      PG8_BAR; }
    for (;;) {
        const bool has_next = P.next(DUP ? ((ui + 1) >> 1) : (ui + 1), nxt);
        if (!has_next) nxt = cur;
        if constexpr (Prob::GATHER) {
#pragma unroll
            for (int i = 0; i < 2; ++i) { nA0[i] = P.a_off(nxt, 0, Rs[i], Cs[i]); nA1[i] = P.a_off(nxt, 1, Rs[i], Cs[i]); } }
#ifdef PROBE_KL
        unsigned long long tk0_ = 0; if constexpr (Epi::ID == PROBE_KL) tk0_ = __builtin_amdgcn_s_memrealtime();
#endif
        for (int t = 0; t < nt; t += 2) {
            const bool last = (t == nt - 2);
            if (last && has_next) P.a_ready(nxt, tid);
            const char* a1 = P.a_base(cur, t + 1);
            const char* a2 = last ? P.a_base(nxt, 0) : P.a_base(cur, t + 2); const char* b2 = last ? P.b_base(nxt, 0) : P.b_base(cur, t + 2);
            const char* a3 = last ? P.a_base(nxt, 1) : P.a_base(cur, t + 3); const char* b3 = last ? P.b_base(nxt, 1) : P.b_base(cur, t + 3);
            unsigned xA0[2], xA1[2];
#pragma unroll
            for (int i = 0; i < 2; ++i) { xA0[i] = (Prob::GATHER && last) ? nA0[i] : cA0[i]; xA1[i] = (Prob::GATHER && last) ? nA1[i] : cA1[i]; }
            PG8_LDB(B0, 0, 0); if constexpr (NB == 2) PG8_LDB(B1, 0, 1); PG8_SCHED; PG8_LDA(At, 0, 0); PG8_STAGE(PG8_SA(1, 1), a1, cA1);
            PG8_WAIT_LOOP; PG8_WAIT_L(0); PG8_BAR; PG8_MMA(0, 0, At, B0); if constexpr (NB == 2) PG8_MMA(0, NB - 1, At, B1); PG8_BAR; PG8_SCHED;
            PG8_LDA(At, 0, 1); PG8_STAGE(PG8_SB(0, 0), b2, voffB); if constexpr (NB == 2) PG8_STAGE(PG8_SB(0, 1), b2 + hstepB, voffB); PG8_STAGE(PG8_SA(0, 0), a2, xA0);
            PG8_WAIT_LOOP; PG8_WAIT_L(0); PG8_BAR; PG8_MMA(1, 0, At, B0); if constexpr (NB == 2) PG8_MMA(1, NB - 1, At, B1); PG8_BAR; PG8_SCHED;
            PG8_LDB(B0, 1, 0); if constexpr (NB == 2) PG8_LDB(B1, 1, 1); PG8_SCHED; PG8_LDA(At, 1, 0); PG8_STAGE(PG8_SA(0, 1), a2, xA1);
            PG8_WAIT_LOOP; PG8_WAIT_L(0); PG8_BAR; PG8_MMA(0, 0, At, B0); if constexpr (NB == 2) PG8_MMA(0, NB - 1, At, B1); PG8_BAR; PG8_SCHED;
            PG8_LDA(At, 1, 1); PG8_STAGE(PG8_SB(1, 0), b3, voffB); if constexpr (NB == 2) PG8_STAGE(PG8_SB(1, 1), b3 + hstepB, voffB); PG8_STAGE(PG8_SA(1, 0), a3, xA0);
            PG8_WAIT_LOOP; PG8_WAIT_L(0); PG8_BAR; PG8_MMA(1, 0, At, B0); if constexpr (NB == 2) PG8_MMA(1, NB - 1, At, B1); PG8_BAR; PG8_SCHED;
        }
#ifdef PROBE_KL
        if constexpr (Epi::ID == PROBE_KL) { if (tid == 0) *(volatile LAS unsigned long long*)(lds + MISC_OFF + 64) += __builtin_amdgcn_s_memrealtime() - tk0_; }
#endif
        if constexpr (ALIGN_EPI) { if (wr == 0) PG8_BAR; }
#ifdef PROBE_GE
        unsigned long long tg0_ = 0; if constexpr (Epi::ID == PROBE_GE) tg0_ = __builtin_amdgcn_s_memrealtime();
#endif
        if constexpr (Epi::WANTS_NEXT) E(acc, cur, nxt, has_next, wr, wc, fr, fq);
        else if (!DUP || (ui & 1)) E(acc, cur, wr, wc, fr, fq);
        P.done(cur, lane);
#ifdef PROBE_GE
        if constexpr (Epi::ID == PROBE_GE) { if (PROBE_GW == 1) asm volatile("s_waitcnt vmcnt(0)" ::: "memory"); if (tid == 0) *(volatile LAS unsigned long long*)(lds + MISC_OFF + 64) += __builtin_amdgcn_s_memrealtime() - tg0_; }
#endif
#ifdef PROBE_EPI2
        if constexpr (Epi::PROBE2) E(acc, cur, wr, wc, fr, fq);
#endif
        if (!has_next) break;
#pragma unroll
        for (int a = 0; a < 2; ++a)
#pragma unroll
            for (int b = 0; b < NB; ++b)
#pragma unroll
                for (int m = 0; m < 4; ++m)
#pragma unroll
                    for (int n = 0; n < 2; ++n) acc[a][b][m][n] = (f32x4){0.f, 0.f, 0.f, 0.f};
        cur = nxt; ++ui;
        if constexpr (Prob::GATHER) {
#pragma unroll
            for (int i = 0; i < 2; ++i) { cA0[i] = nA0[i]; cA1[i] = nA1[i]; } }
        if constexpr (ALIGN_EPI) { if (wr == 1) PG8_BAR; }
    }
    PG8_WAIT_V(0);
    if constexpr (!ALIGN_EPI) { if (wr == 0) PG8_BAR; }
    PG8_BAR;
#undef PG8_SA
#undef PG8_SB
#undef PG8_STAGE
#undef PG8_LDA
#undef PG8_LDB
#undef PG8_MMA
#undef PG8_WAIT_V
#undef PG8_WAIT_L
#undef PG8_WAIT_LOOP
#undef PG8_BAR
#undef PG8_SCHED
}

template <bool WT = false>
__device__ __forceinline__ void store_lines(bf16_t* rowp16, int ldc, int fr, int fq, const u32x4 v0, const u32x4 v1) {
    const bool lo = fr < 8;
    u32x4 x = lo ? v1 : v0, y;
    y.x = __shfl_xor((int)x.x, 8); y.y = __shfl_xor((int)x.y, 8); y.z = __shfl_xor((int)x.z, 8); y.w = __shfl_xor((int)x.w, 8);
    bf16_t* p = rowp16 + (size_t)(fr & 7) * ldc + (lo ? 0 : 32) + 8 * fq;
    if constexpr (WT) {
        const u32x4 a_ = lo ? v0 : y, b_ = lo ? y : v1;
        unsigned long long* q = (unsigned long long*)p; unsigned long long* q2 = (unsigned long long*)(p + (size_t)8 * ldc);
        __hip_atomic_store(q, (unsigned long long)a_.x | ((unsigned long long)a_.y << 32), __ATOMIC_RELAXED, __HIP_MEMORY_SCOPE_AGENT);
        __hip_atomic_store(q + 1, (unsigned long long)a_.z | ((unsigned long long)a_.w << 32), __ATOMIC_RELAXED, __HIP_MEMORY_SCOPE_AGENT);
        __hip_atomic_store(q2, (unsigned long long)b_.x | ((unsigned long long)b_.y << 32), __ATOMIC_RELAXED, __HIP_MEMORY_SCOPE_AGENT);
        __hip_atomic_store(q2 + 1, (unsigned long long)b_.z | ((unsigned long long)b_.w << 32), __ATOMIC_RELAXED, __HIP_MEMORY_SCOPE_AGENT);
        return;
    }
#ifdef NT_STORES
    __builtin_nontemporal_store(lo ? v0 : y, (u32x4*)p);
    __builtin_nontemporal_store(lo ? y : v1, (u32x4*)(p + (size_t)8 * ldc));
#else
    *(u32x4*)p = lo ? v0 : y;
    *(u32x4*)(p + (size_t)8 * ldc) = lo ? y : v1;
#endif
}
#ifndef GATE_LOGIT
#define GATE_LOGIT 0
#endif
struct EpiStore {
    static constexpr bool PERM = true, PROBE2 = true, WANTS_NEXT = false; static constexpr int ID = 1;
    bf16_t* O; int ldc; int gate_pn0; const LAS float* gbias; bf16_t* gates;
    __device__ __forceinline__ void operator()(const f32x4 (&acc)[2][2][4][2], const Unit& u, int wr, int wc, int fr, int fq) const {
        const int row0 = u.pm * BM + wr * 64, colw = u.pn * BM + wc * 64, col0 = colw + 8 * fq;
        const bool gate = u.pn >= gate_pn0;
        const int tid_ = (wr * 4 + wc) * 64 + fq * 16 + fr;
        f32x4 bv[2][2];
#pragma unroll
        for (int bj = 0; bj < 2; ++bj)
#pragma unroll
            for (int n = 0; n < 2; ++n) bv[bj][n] = gate ? *(const LAS f32x4*)(gbias + (col0 - gate_pn0 * BM) + bj * 32 + 4 * n) : (f32x4){0.f, 0.f, 0.f, 0.f};
        bf16_t* gt = gates + ((size_t)(u.pm * 12 + (u.pn - gate_pn0)) * 65536) + tid_ * 8;
#pragma unroll
        for (int ai = 0; ai < 2; ++ai)
#pragma unroll
            for (int m = 0; m < 4; ++m) {
                u32x4 w[2];
#pragma unroll
                for (int bj = 0; bj < 2; ++bj) { f32x4 v0 = acc[ai][bj][m][0] + bv[bj][0], v1 = acc[ai][bj][m][1] + bv[bj][1];
                    if (gate && !GATE_LOGIT) {
#pragma unroll
                        for (int j = 0; j < 4; ++j) { v0[j] = sigmoidf_(v0[j]); v1[j] = sigmoidf_(v1[j]); } }
                    w[bj].x = pk2(v0[0], v0[1]); w[bj].y = pk2(v0[2], v0[3]); w[bj].z = pk2(v1[0], v1[1]); w[bj].w = pk2(v1[2], v1[3]); }
                if (gate) { __builtin_nontemporal_store(w[0], (u32x4*)(gt + (size_t)(((ai * 4 + m) * 2 + 0) * 4096))); __builtin_nontemporal_store(w[1], (u32x4*)(gt + (size_t)(((ai * 4 + m) * 2 + 1) * 4096))); }
                else store_lines(O + (size_t)(row0 + ai * HALF + m * 16) * ldc + colw, ldc, fr, fq, w[0], w[1]);
            }
    }
};
struct EpiStoreH {
    static constexpr bool PERM = true, PROBE2 = false, WANTS_NEXT = false; static constexpr int ID = 6;
    bf16_t* O; int ldc; int gate_pn0; const LAS float* gbias; bf16_t* gates;
    __device__ __forceinline__ void operator()(const f32x4 (&acc)[2][1][4][2], const Unit& u, int wr, int wc, int fr, int fq) const {
        const int half = u.x0, row0 = u.pm * BM + wr * 64, colt = half * 128 + wc * 32 + 8 * fq;
        const bool gate = u.pn >= gate_pn0;
        f32x4 bv[2];
#pragma unroll
        for (int n = 0; n < 2; ++n) bv[n] = gate ? *(const LAS f32x4*)(gbias + (u.pn - gate_pn0) * BM + colt + 4 * n) : (f32x4){0.f, 0.f, 0.f, 0.f};
        const int wco = 2 * half + (wc >> 1), bjo = wc & 1, tid_ = (wr * 4 + wco) * 64 + fq * 16 + fr;
        bf16_t* gt = gates + ((size_t)(u.pm * 12 + (u.pn - gate_pn0)) * 65536) + bjo * 4096 + tid_ * 8;
#pragma unroll
        for (int ai = 0; ai < 2; ++ai)
#pragma unroll
            for (int m = 0; m < 4; ++m) {
                f32x4 v0 = acc[ai][0][m][0] + bv[0], v1 = acc[ai][0][m][1] + bv[1];
                if (gate && !GATE_LOGIT) {
#pragma unroll
                    for (int j = 0; j < 4; ++j) { v0[j] = sigmoidf_(v0[j]); v1[j] = sigmoidf_(v1[j]); } }
                u32x4 w; w.x = pk2(v0[0], v0[1]); w.y = pk2(v0[2], v0[3]); w.z = pk2(v1[0], v1[1]); w.w = pk2(v1[2], v1[3]);
                if (gate) __builtin_nontemporal_store(w, (u32x4*)(gt + (size_t)((ai * 4 + m) * 8192)));
                else __builtin_nontemporal_store(w, (u32x4*)(O + (size_t)(row0 + ai * HALF + m * 16 + fr) * ldc + u.pn * BM + colt));
            }
    }
};
struct EpiStoreR {
    static constexpr bool PERM = true, PROBE2 = false, WANTS_NEXT = false; static constexpr int ID = 7;
    bf16_t* O; int ldc; const LAS float* rs;
    __device__ __forceinline__ void operator()(const f32x4 (&acc)[2][2][4][2], const Unit& u, int wr, int wc, int fr, int fq) const {
        const int row0 = u.pm * BM + wr * 64, colw = u.pn * BM + wc * 64;
#pragma unroll
        for (int ai = 0; ai < 2; ++ai)
#pragma unroll
            for (int m = 0; m < 4; ++m) {
                const float r = rs[wr * 64 + ai * HALF + m * 16 + fr];
                u32x4 w[2];
#pragma unroll
                for (int bj = 0; bj < 2; ++bj) { const f32x4 v0 = acc[ai][bj][m][0] * r, v1 = acc[ai][bj][m][1] * r;
                    w[bj].x = pk2(v0[0], v0[1]); w[bj].y = pk2(v0[2], v0[3]); w[bj].z = pk2(v1[0], v1[1]); w[bj].w = pk2(v1[2], v1[3]); }
                store_lines(O + (size_t)(row0 + ai * HALF + m * 16) * ldc + colw, ldc, fr, fq, w[0], w[1]);
            }
    }
};
struct EpiResid {
    static constexpr bool PERM = false, PROBE2 = false, WANTS_NEXT = false; static constexpr int ID = 2;
    const float* xin; float* out; int ldc;
    __device__ __forceinline__ void operator()(const f32x4 (&acc)[2][2][4][2], const Unit& u, int wr, int wc, int fr, int fq) const {
        const int row0 = u.pm * BM + wr * 64 + fr, col0 = u.pn * BM + wc * 32 + 4 * fq;
#pragma unroll
        for (int ai = 0; ai < 2; ++ai) {
            f32x4 bs[4][2][2];
#pragma unroll
            for (int m = 0; m < 4; ++m) { const size_t off = (size_t)(row0 + ai * HALF + m * 16) * ldc + col0;
#pragma unroll
                for (int bj = 0; bj < 2; ++bj)
#pragma unroll
                    for (int n = 0; n < 2; ++n) bs[m][bj][n] = *(const f32x4*)(xin + off + bj * HALF + n * 16); }
            asm volatile("" ::: "memory");
#pragma unroll
            for (int m = 0; m < 4; ++m) { const size_t off = (size_t)(row0 + ai * HALF + m * 16) * ldc + col0;
#pragma unroll
                for (int bj = 0; bj < 2; ++bj)
#pragma unroll
                    for (int n = 0; n < 2; ++n) *(f32x4*)(out + off + bj * HALF + n * 16) = bs[m][bj][n] + acc[ai][bj][m][n]; }
            asm volatile("" ::: "memory");
        }
    }
};
template <bool WT = false>
struct EpiResidB {
    static constexpr bool PERM = true, PROBE2 = false, WANTS_NEXT = false; static constexpr int ID = 2;
    bf16_t* xb; float* ssq2 = nullptr;
    __device__ __forceinline__ void operator()(const f32x4 (&acc)[2][2][4][2], const Unit& u, int wr, int wc, int fr, int fq) const {
        const int row0 = u.pm * BM + wr * 64, colw = u.pn * BM + wc * 64;
#pragma unroll
        for (int ai = 0; ai < 2; ++ai) {
            u32x4 xo[4][2];
#pragma unroll
            for (int m = 0; m < 4; ++m)
#pragma unroll
                for (int bj = 0; bj < 2; ++bj) xo[m][bj] = *(const u32x4*)(xb + (size_t)(row0 + ai * HALF + m * 16 + fr) * DM + colw + bj * 32 + 8 * fq);
            asm volatile("" ::: "memory");
#pragma unroll
            for (int m = 0; m < 4; ++m) {
                u32x4 w[2];
#pragma unroll
                for (int bj = 0; bj < 2; ++bj) { const u32x4 o = xo[m][bj]; const f32x4 a0 = acc[ai][bj][m][0], a1 = acc[ai][bj][m][1];
                    w[bj].x = pk2(bf_lo(o.x) + a0[0], bf_hi(o.x) + a0[1]); w[bj].y = pk2(bf_lo(o.y) + a0[2], bf_hi(o.y) + a0[3]);
                    w[bj].z = pk2(bf_lo(o.z) + a1[0], bf_hi(o.z) + a1[1]); w[bj].w = pk2(bf_lo(o.w) + a1[2], bf_hi(o.w) + a1[3]); }
                store_lines<WT>(xb + (size_t)(row0 + ai * HALF + m * 16) * DM + colw, DM, fr, fq, w[0], w[1]);
                if (ssq2) {
                    float sq = 0.f;
#pragma unroll
                    for (int bj = 0; bj < 2; ++bj) { const u32x4 t = w[bj];
                        sq += (bf_lo(t.x) * bf_lo(t.x) + bf_hi(t.x) * bf_hi(t.x)) + (bf_lo(t.y) * bf_lo(t.y) + bf_hi(t.y) * bf_hi(t.y)) + (bf_lo(t.z) * bf_lo(t.z) + bf_hi(t.z) * bf_hi(t.z)) + (bf_lo(t.w) * bf_lo(t.w) + bf_hi(t.w) * bf_hi(t.w)); }
                    sq += __shfl_xor(sq, 16); sq += __shfl_xor(sq, 32);
                    if (fq == 0) ssq2[(size_t)(row0 + ai * HALF + m * 16 + fr) * 16 + u.pn * 4 + wc] = sq;
                }
            }
            asm volatile("" ::: "memory");
        }
    }
};
}
struct Args { const float* in[35]; float* out; unsigned char* ws; int s_lo, s_hi; };
#define AS4 __attribute__((address_space(4)))
struct InProxy { const AS4 unsigned char* ka; __device__ __forceinline__ const float* operator[](int k) const { return *(const float* const AS4*)(ka + 8 * k); } };
struct ArgsV { InProxy in; float* out; unsigned char* ws; };
struct Frame {
    LAS unsigned char* lds;
    int tid, lane, wave, vcu, G;
};

#ifndef PREP_ORDER
#define PREP_ORDER 0
#endif
#ifndef XQ_FOLD
#define XQ_FOLD 1
#endif
#ifndef MOE_FOLD
#define MOE_FOLD 1
#endif
struct TrDesc { const float* src; bf16_t* dst; const float* kscale; int ld, col0, dld, drow0, k0, n0; float scale; int ilv; };
__device__ __forceinline__ void tr_load(const TrDesc& d, int lane, f32x4 (&v)[16]) {
#pragma unroll
    for (int i = 0; i < 16; ++i) v[i] = *(const f32x4*)(d.src + (size_t)(d.k0 + 4 * i + (lane >> 4)) * d.ld + d.col0 + d.n0 + 4 * (lane & 15));
}
__device__ __forceinline__ void tr_store(const TrDesc& d, const f32x4 (&v)[16], LAS float* scr, int lane) {
#pragma unroll
    for (int i = 0; i < 16; ++i) { LAS float* q = scr + (4 * i + (lane >> 4)) * 65 + 4 * (lane & 15); q[0] = v[i].x; q[1] = v[i].y; q[2] = v[i].z; q[3] = v[i].w; }
    LDS_WAIT(); asm volatile("" ::: "memory");
    const int c = lane & 7;
    float ks[8];
#pragma unroll
    for (int q = 0; q < 8; ++q) ks[q] = d.kscale ? d.kscale[d.k0 + 8 * c + q] * d.scale : d.scale;
#pragma unroll
    for (int j = 0; j < 8; ++j) { const int n = (lane >> 3) + 8 * j; const LAS float* s = scr + (8 * c) * 65 + n;
        u32x4 o; o.x = pk2(s[0 * 65] * ks[0], s[1 * 65] * ks[1]); o.y = pk2(s[2 * 65] * ks[2], s[3 * 65] * ks[3]); o.z = pk2(s[4 * 65] * ks[4], s[5 * 65] * ks[5]); o.w = pk2(s[6 * 65] * ks[6], s[7 * 65] * ks[7]);
        const int nn = d.n0 + n, drow = d.ilv ? d.drow0 + (nn >> 5) * 64 + (nn & 31) : d.drow0 + nn;
        *(u32x4*)(d.dst + (size_t)drow * d.dld + d.k0 + 8 * c) = o; }
    LDS_WAIT(); asm volatile("" ::: "memory");
}
__device__ __forceinline__ void pool_fold_wg(const Frame& F, const float* w_in, const float* wg, const float* pscale, bf16_t* wt_in, int item) {
    const int g = item >> 6, k0 = (item & 63) * 16, lane = F.lane;
    LAS float* wl = (LAS float*)F.lds;
    LAS float* scr = (LAS float*)(F.lds + 65536 + F.wave * 1024);
    LAS float* res = (LAS float*)(F.lds + 65536 + 8192);
    const float* wgg = wg + (size_t)g * 128 * 128;
    f32x4 t4[8];
#pragma unroll
    for (int i = 0; i < 8; ++i) t4[i] = *(const f32x4*)(wgg + (F.tid + i * NTHR) * 4);
    const float u0 = w_in[(size_t)(k0 + F.wave * 2) * IN_COLS + PU + g * 128 + lane], u1 = w_in[(size_t)(k0 + F.wave * 2) * IN_COLS + PU + g * 128 + 64 + lane];
    const float u2 = w_in[(size_t)(k0 + F.wave * 2 + 1) * IN_COLS + PU + g * 128 + lane], u3 = w_in[(size_t)(k0 + F.wave * 2 + 1) * IN_COLS + PU + g * 128 + 64 + lane];
#pragma unroll
    for (int i = 0; i < 8; ++i) *(LAS f32x4*)(wl + (F.tid + i * NTHR) * 4) = t4[i];
    scr[lane] = u0; scr[64 + lane] = u1; scr[128 + lane] = u2; scr[192 + lane] = u3;
    __syncthreads();
    float a00 = 0.f, a01 = 0.f, a10 = 0.f, a11 = 0.f;
#pragma unroll 8
    for (int j = 0; j < 128; ++j) { const float w0 = wl[j * 128 + lane], w1 = wl[j * 128 + 64 + lane]; const float x0 = scr[j], x1 = scr[128 + j];
        a00 += x0 * w0; a01 += x0 * w1; a10 += x1 * w0; a11 += x1 * w1; }
    const float s0 = pscale[g * 128 + lane], s1 = pscale[g * 128 + 64 + lane];
    res[(F.wave * 2) * 129 + lane] = a00 * s0; res[(F.wave * 2) * 129 + 64 + lane] = a01 * s1; res[(F.wave * 2 + 1) * 129 + lane] = a10 * s0; res[(F.wave * 2 + 1) * 129 + 64 + lane] = a11 * s1;
    __syncthreads();
    if (F.tid < 128) {
        float v[16];
#pragma unroll
        for (int kk = 0; kk < 16; ++kk) v[kk] = res[kk * 129 + F.tid];
        u32x4 o; bf16_t* d0 = wt_in + (size_t)(PU + g * 128 + F.tid) * DM + k0;
        o.x = pk2(v[0], v[1]); o.y = pk2(v[2], v[3]); o.z = pk2(v[4], v[5]); o.w = pk2(v[6], v[7]); *(u32x4*)d0 = o;
        o.x = pk2(v[8], v[9]); o.y = pk2(v[10], v[11]); o.z = pk2(v[12], v[13]); o.w = pk2(v[14], v[15]); *(u32x4*)(d0 + 8) = o;
    }
    __syncthreads();
}

constexpr float QSCALE = 0.125f * LOG2E;
constexpr int PREP_HEAVY = 320;
__device__ __forceinline__ void prep_weights(const Frame& F, const ArgsV& args, int l) {
    unsigned char* wsw = args.ws + WS_W;
    bf16_t* wt_in = (bf16_t*)(wsw + W_IN);
    LAS float* scr = (LAS float*)(F.lds + F.wave * 16640);
    const int gw = F.vcu * NWAVES + F.wave, NGW = F.G * NWAVES;
    const float* w_in = args.in[2] + (size_t)l * DM * IN_COLS;
    constexpr int I_POOL = 0, I_Q = 128, I_KV = 256, I_ZX = 320, I_G = 768, I_BR = 384, I_MIX = 256, I_XQ = 64, I_XKV = 128, I_XO = 64, I_EG = 2048, I_EU = 2048, I_ED = 2048;
    constexpr int NITEMS = I_POOL + I_Q + I_KV + I_ZX + I_G + I_BR + I_MIX + I_XQ + I_XKV + I_XO + I_EG + I_EU + I_ED;
    for (int it = F.vcu; it < 256; it += F.G) pool_fold_wg(F, w_in, args.in[10] + (size_t)l * 4 * 128 * 128, args.in[11] + (size_t)l * 512, wt_in, it);
    auto kn = [](int x, int NN, int& k0, int& n0) {
#if PREP_ORDER == 1
        const int g = x >> 3, j = x & 7, h = NN >> 1; n0 = (2 * (g % h) + (j & 1)) * 64; k0 = (4 * (g / h) + (j >> 1)) * 64;
#else
        k0 = (x / NN) * 64; n0 = (x % NN) * 64;
#endif
    };
    auto decode = [&](int r, TrDesc& d) {
        d.kscale = nullptr; d.scale = 1.f; d.ilv = 0; d.col0 = 0; d.drow0 = 0;
        if (r < I_Q) { d.src = w_in; d.ld = IN_COLS; d.dst = wt_in; d.dld = DM; kn(r, 8, d.k0, d.n0); d.scale = QSCALE; return; } r -= I_Q;
        if (r < I_KV) { d.src = w_in; d.ld = IN_COLS; d.col0 = 512; d.dst = wt_in; d.dld = DM; d.drow0 = 512; kn(r, 16, d.k0, d.n0); return; } r -= I_KV;
        if (r < I_ZX) { d.src = w_in; d.ld = IN_COLS; d.col0 = 2048; d.dst = wt_in; d.dld = DM; d.drow0 = 2048; kn(r, 20, d.k0, d.n0); return; } r -= I_ZX;
        if (r < I_G) { d.src = w_in; d.ld = IN_COLS; d.col0 = COL_GATE; d.dst = wt_in; d.dld = DM; d.drow0 = PG; kn(r, 48, d.k0, d.n0); return; } r -= I_G;
        if (r < I_BR) { const int b = r / 128, q = r % 128; d.src = args.in[18] + (size_t)(l * 3 + b) * 512 * 1024; d.ld = 1024; d.dst = (bf16_t*)(wsw + W_BR) + (size_t)b * 1024 * 512; d.dld = 512; kn(q, 16, d.k0, d.n0);
            d.kscale = (b == 2) ? args.in[17] + (size_t)l * 512 : nullptr; return; } r -= I_BR;
        if (r < I_MIX) { d.src = args.in[19] + (size_t)l * 1024 * 1024; d.ld = 1024; d.dst = (bf16_t*)(wsw + W_MIX); d.dld = 1024; kn(r, 16, d.k0, d.n0); return; } r -= I_MIX;
        if (r < I_XQ) { d.src = args.in[23] + (size_t)l * 1024 * 256; d.ld = 256; d.dst = (bf16_t*)(wsw + W_XQ); d.dld = 1024; kn(r, 4, d.k0, d.n0); d.scale = QSCALE; if (XQ_FOLD) d.kscale = args.in[21] + (size_t)l * DM; return; } r -= I_XQ;
        if (r < I_XKV) { d.src = args.in[24] + (size_t)l * 1024 * 512; d.ld = 512; d.dst = (bf16_t*)(wsw + W_XKV); d.dld = 1024; kn(r, 8, d.k0, d.n0); return; } r -= I_XKV;
        if (r < I_XO) { d.src = args.in[25] + (size_t)l * 256 * 1024; d.ld = 1024; d.dst = (bf16_t*)(wsw + W_XO); d.dld = 256; kn(r, 16, d.k0, d.n0); return; } r -= I_XO;
        if (r < I_EG + I_EU) { const int up = r >= I_EG; if (up) r -= I_EG; const int e = r / 128, q = r % 128;
            d.src = args.in[up ? 32 : 31] + (size_t)(l * 16 + e) * 1024 * 512; d.ld = 512; d.dst = (bf16_t*)(wsw + W_GU); d.dld = 1024; d.drow0 = e * 1024 + (up ? 32 : 0); kn(q, 8, d.k0, d.n0); d.ilv = 1; if (MOE_FOLD) d.kscale = args.in[26] + (size_t)l * DM; return; } r -= I_EG + I_EU;
        { const int e = r / 128, q = r % 128; d.src = args.in[33] + (size_t)(l * 16 + e) * 512 * 1024; d.ld = 1024; d.dst = (bf16_t*)(wsw + W_DN) + (size_t)e * 1024 * 512; d.dld = 512; kn(q, 16, d.k0, d.n0); }
    };
    TrDesc dA, dB; f32x4 vA[16], vB[16];
    int it = gw;
    static_assert(NITEMS - 4 * 2048 == PREP_HEAVY, "row split of the norm pass assumes this");
    if (it < NITEMS) { decode(it, dA); tr_load(dA, F.lane, vA); }
    while (it < NITEMS) {
        const int it2 = it + NGW, it3 = it2 + NGW;
        if (it2 < NITEMS) { decode(it2, dB); tr_load(dB, F.lane, vB); }
        tr_store(dA, vA, scr, F.lane);
        if (it2 < NITEMS) { if (it3 < NITEMS) { decode(it3, dA); tr_load(dA, F.lane, vA); } tr_store(dB, vB, scr, F.lane); }
        it = it3;
    }
}

__device__ __forceinline__ void load_row(const float* xrow, int lane, f32x4 (&v)[4]) {
#pragma unroll
    for (int j = 0; j < 4; ++j) v[j] = ((const f32x4*)xrow + lane)[64 * j];
}
__device__ __forceinline__ void load_row_b(const bf16_t* xrow, int lane, f32x4 (&v)[4]) {
#pragma unroll
    for (int j = 0; j < 4; ++j) { const u32x2 w = ((const u32x2*)xrow + lane)[64 * j]; v[j] = (f32x4){bf_lo(w.x), bf_hi(w.x), bf_lo(w.y), bf_hi(w.y)}; }
}
__device__ __forceinline__ void load_raw_b(const bf16_t* xrow, int lane, u32x2 (&r)[4]) {
#pragma unroll
    for (int j = 0; j < 4; ++j) r[j] = ((const u32x2*)xrow + lane)[64 * j];
}
__device__ __forceinline__ void widen_b(const u32x2 (&r)[4], f32x4 (&v)[4]) {
#pragma unroll
    for (int j = 0; j < 4; ++j) v[j] = (f32x4){bf_lo(r[j].x), bf_hi(r[j].x), bf_lo(r[j].y), bf_hi(r[j].y)};
}
__device__ __forceinline__ void norm_apply(const f32x4 (&xv)[4], const f32x4 (&gv)[4], bf16_t* orow, int lane, f32x4 (&hv)[4]) {
    float s = 0.f;
#pragma unroll
    for (int j = 0; j < 4; ++j) s += (xv[j].x * xv[j].x + xv[j].y * xv[j].y) + (xv[j].z * xv[j].z + xv[j].w * xv[j].w);
    const float rstd = 1.0f / sqrtf(wave_sum(s) * (1.f / DM) + EPS);
    unsigned long long* o8 = (unsigned long long*)orow + lane;
#pragma unroll
    for (int j = 0; j < 4; ++j) { hv[j] = xv[j] * rstd * gv[j]; o8[64 * j] = (unsigned long long)pk2(hv[j].x, hv[j].y) | ((unsigned long long)pk2(hv[j].z, hv[j].w) << 32); }
}
__device__ __forceinline__ void load_gain(const float* g, int lane, f32x4 (&gv)[4]) {
#pragma unroll
    for (int j = 0; j < 4; ++j) gv[j] = ((const f32x4*)g + lane)[64 * j];
}
__device__ __forceinline__ void norm_rows_plain(const Frame& F, const float* x, const float* g, bf16_t* H, int nrows) {
    const int gw = F.vcu * NWAVES + F.wave, NGW = F.G * NWAVES;
    f32x4 gv[4], hv[4], cur[4], nxt[4]; load_gain(g, F.lane, gv);
    if (gw < nrows) load_row(x + (size_t)gw * DM, F.lane, cur);
    for (int m = gw; m < nrows; m += NGW) {
        const int mn = (m + NGW < nrows) ? m + NGW : m;
        load_row(x + (size_t)mn * DM, F.lane, nxt);
        norm_apply(cur, gv, H + (size_t)m * DM, F.lane, hv);
#pragma unroll
        for (int j = 0; j < 4; ++j) cur[j] = nxt[j];
    }
}
__device__ __forceinline__ void norm_rows_plain_b(const Frame& F, const bf16_t* x, const float* g, bf16_t* H, int nrows) {
    const int gw = F.vcu * NWAVES + F.wave, NGW = F.G * NWAVES;
    f32x4 gv[4], hv[4], cur[4], nxt[4]; load_gain(g, F.lane, gv);
    if (gw < nrows) load_row_b(x + (size_t)gw * DM, F.lane, cur);
    for (int m = gw; m < nrows; m += NGW) {
        const int mn = (m + NGW < nrows) ? m + NGW : m;
        load_row_b(x + (size_t)mn * DM, F.lane, nxt);
        norm_apply(cur, gv, H + (size_t)m * DM, F.lane, hv);
#pragma unroll
        for (int j = 0; j < 4; ++j) cur[j] = nxt[j];
    }
}
__device__ __forceinline__ void norm_rows_dt(const Frame& F, const float* x32, bf16_t* xb, const bool first, const float* g, bf16_t* H, const float* w_in, float* DT, const int gw, const int NGW, const int T) {
    const int lane = F.lane;
    f32x4 gv[4], hv[4], cur[4]; load_gain(g, lane, gv);
    f32x4 wd[4][4][2];
#pragma unroll
    for (int j = 0; j < 4; ++j)
#pragma unroll
        for (int i = 0; i < 4; ++i) { const float* p = w_in + (size_t)(4 * lane + 256 * j + i) * IN_COLS + COL_DT; wd[j][i][0] = *(const f32x4*)p; wd[j][i][1] = *(const f32x4*)(p + 4); }
    const bool hi = lane >= 32, b4 = (lane >> 4) & 1, b3 = (lane >> 3) & 1;
    auto consume = [&](const f32x4 (&cur)[4], const int m) {
        norm_apply(cur, gv, H + (size_t)m * DM, lane, hv);
        f32x4 d0 = {0.f, 0.f, 0.f, 0.f}, d1 = {0.f, 0.f, 0.f, 0.f};
#pragma unroll
        for (int j = 0; j < 4; ++j)
#pragma unroll
            for (int i = 0; i < 4; ++i) { d0 += wd[j][i][0] * hv[j][i]; d1 += wd[j][i][1] * hv[j][i]; }
        float a[4];
#pragma unroll
        for (int q = 0; q < 4; ++q) { const float keep = hi ? d1[q] : d0[q], send = hi ? d0[q] : d1[q]; a[q] = keep + __shfl_xor(send, 32); }
        float b[2];
#pragma unroll
        for (int q = 0; q < 2; ++q) { const float keep = b4 ? a[2 + q] : a[q], send = b4 ? a[q] : a[2 + q]; b[q] = keep + __shfl_xor(send, 16); }
        float c = (b3 ? b[1] : b[0]) + __shfl_xor(b3 ? b[0] : b[1], 8);
        c += __shfl_xor(c, 4); c += __shfl_xor(c, 2); c += __shfl_xor(c, 1);
        if ((lane & 7) == 0) DT[(size_t)m * 8 + (hi ? 4 : 0) + (b4 ? 2 : 0) + (b3 ? 1 : 0)] = c;
    };
    if (first) {
        f32x4 n1[4], n2[4];
        load_row(x32 + (size_t)gw * DM, lane, cur); load_row(x32 + (size_t)(gw + NGW < T ? gw + NGW : gw) * DM, lane, n1);
        for (int m = gw; m < T; m += NGW) {
            const int m2 = (m + 2 * NGW < T) ? m + 2 * NGW : m;
            load_row(x32 + (size_t)m2 * DM, lane, n2);
            unsigned long long* o8 = (unsigned long long*)(xb + (size_t)m * DM) + lane;
#pragma unroll
            for (int j = 0; j < 4; ++j) o8[64 * j] = (unsigned long long)pk2(cur[j].x, cur[j].y) | ((unsigned long long)pk2(cur[j].z, cur[j].w) << 32);
            consume(cur, m);
#pragma unroll
            for (int j = 0; j < 4; ++j) { cur[j] = n1[j]; n1[j] = n2[j]; }
        }
    } else {
        u32x2 r0[4], r1[4], r2[4];
        load_raw_b(xb + (size_t)gw * DM, lane, r0); load_raw_b(xb + (size_t)(gw + NGW < T ? gw + NGW : gw) * DM, lane, r1);
        for (int m = gw; m < T; m += NGW) {
            const int m2 = (m + 2 * NGW < T) ? m + 2 * NGW : m;
            load_raw_b(xb + (size_t)m2 * DM, lane, r2);
            widen_b(r0, cur);
            consume(cur, m);
#pragma unroll
            for (int j = 0; j < 4; ++j) { r0[j] = r1[j]; r1[j] = r2[j]; }
        }
    }
}
typedef short v4i16_t __attribute__((ext_vector_type(4)));
__device__ __forceinline__ int crow(int r, int hi) { return (r & 3) + 8 * (r >> 2) + 4 * hi; }
__device__ __forceinline__ s16x4 vtr(const LAS unsigned char* p) { return __builtin_bit_cast(s16x4, __builtin_amdgcn_ds_read_tr16_b64_v4i16((LAS v4i16_t*)p)); }

template <int NMAPS, int DV, bool DIFF> __host__ __device__ constexpr int attn_off_bt() { return 2 * 64 * (DIFF ? NMAPS * 128 : NMAPS * 128 + 16) + 2 * 64 * (DIFF ? DV * 2 : DV * 2 + 64) + 8 * 64 * 4; }
template <int NMAPS, int DV, bool DIFF, bool WT = false>
__device__ __forceinline__ void attn_unit(LAS unsigned char* lds, const int tid_in,
                                          const bf16_t* Qp, const int ldq, const bf16_t* Kp, const bf16_t* Vp, const int ldkv, bf16_t* Op, const int ldo,
                                          const int ntiles, const int q0, const float lam, const float* subg, const float oscale) {
    constexpr bool DMA = DIFF;
    constexpr int KP = DMA ? NMAPS * 128 : NMAPS * 128 + 16, VP = DMA ? DV * 2 : DV * 2 + 64, KT = 64 * KP, VT = 64 * VP;
    static_assert(!DMA || (NMAPS == 2 && DV == 128), "DMA path is written for 256-byte K and V rows");
    static_assert(attn_off_bt<NMAPS, DV, DIFF>() == 2 * KT + 2 * VT + 8 * 64 * 4, "bias table offset");
    constexpr int KCH = NMAPS * 8, VCH = DV / 8, KN = (64 * KCH) / NTHR, VN = (64 * VCH) / NTHR, NDV = DV / 32;
    constexpr int OFF_K = 0, OFF_V = 2 * KT, OFF_SC = 2 * KT + 2 * VT, OFF_BT = OFF_SC + 8 * 64 * 4, OFF_Q = OFF_BT + 1024;
    constexpr bool QLDS = DIFF;
    static_assert(OFF_Q + (QLDS ? 256 * KP : 0) <= RING_BYTES, "attention LDS");
    int tid = tid_in; asm volatile("" : "+v"(tid));
    const int lane = tid & 63, wave = __builtin_amdgcn_readfirstlane(tid >> 6), r32 = lane & 31, hi = lane >> 5;
    LAS float* sc = (LAS float*)(lds + OFF_SC) + wave * 64;
    const LAS float* btab = (const LAS float*)(lds + OFF_BT);
    bf16x8 qf[QLDS ? 1 : NMAPS][4];
    const LAS unsigned char* qb_ = lds + OFF_Q + (wave * 32 + r32) * KP + (DMA ? 0 : hi * 16);
    const int xsw = r32 & 15;
    if constexpr (QLDS) {
#pragma unroll
        for (int i = 0; i < (32 * KCH) / 64; ++i) { const int c_ = lane + i * 64, row_ = c_ / KCH, ch_ = c_ % KCH;
            *(LAS u32x4*)(lds + OFF_Q + (wave * 32 + row_) * KP + ((DMA ? (ch_ ^ (row_ & 15)) : ch_) * 16)) = *(const u32x4*)(Qp + (size_t)(wave * 32 + row_) * ldq + ch_ * 8); }
    } else {
#pragma unroll
        for (int m = 0; m < NMAPS; ++m)
#pragma unroll
            for (int d0 = 0; d0 < 4; ++d0) qf[m][d0] = *(const bf16x8*)(Qp + (size_t)(wave * 32 + r32) * ldq + m * 64 + d0 * 16 + hi * 8);
    }
    f32x16 O[NMAPS][NDV];
#pragma unroll
    for (int m = 0; m < NMAPS; ++m)
#pragma unroll
        for (int d = 0; d < NDV; ++d)
            { const float z = zero_v();
#pragma unroll
            for (int r = 0; r < 16; ++r) O[m][d][r] = z; }
    float mrun[NMAPS], lrun[NMAPS];
#pragma unroll
    for (int m = 0; m < NMAPS; ++m) { mrun[m] = -INFINITY; lrun[m] = 0.f; }
    const int my_last = DIFF ? (q0 + 32 * wave) / 64 : ntiles - 1;
    const int qpos = q0 + 32 * wave + r32;
    u32x4 kreg[DMA ? 1 : KN], vreg[DMA ? 1 : VN];
    unsigned dko[2], dvo[2];
    if constexpr (DMA) {
#pragma unroll
        for (int ii = 0; ii < 2; ++ii) { const int row_ = 4 * (2 * wave + ii) + (lane >> 4), p_ = lane & 15;
            dko[ii] = (unsigned)(row_ * ldkv + ((p_ ^ (row_ & 15)) * 8)) * 2u; dvo[ii] = (unsigned)(row_ * ldkv + ((p_ ^ ((row_ & 3) << 2)) * 8)) * 2u; }
    }
#define ATT_LOAD(j) do { if constexpr (!DMA) { _Pragma("unroll") for (int i_ = 0; i_ < KN; ++i_) { const int c_ = tid + i_ * NTHR, row_ = c_ / KCH, ch_ = c_ % KCH; kreg[i_] = *(const u32x4*)(Kp + (size_t)((j) * 64 + row_) * ldkv + ch_ * 8); } \
        _Pragma("unroll") for (int i_ = 0; i_ < VN; ++i_) { const int c_ = tid + i_ * NTHR, row_ = c_ / VCH, ch_ = c_ % VCH; vreg[i_] = *(const u32x4*)(Vp + (size_t)((j) * 64 + row_) * ldkv + ch_ * 8); } } } while (0)
#define ATT_WRITE(buf) do { if constexpr (!DMA) { _Pragma("unroll") for (int i_ = 0; i_ < KN; ++i_) { const int c_ = tid + i_ * NTHR, row_ = c_ / KCH, ch_ = c_ % KCH; *(LAS u32x4*)(lds + OFF_K + (buf) * KT + row_ * KP + ch_ * 16) = kreg[i_]; } \
        _Pragma("unroll") for (int i_ = 0; i_ < VN; ++i_) { const int c_ = tid + i_ * NTHR, row_ = c_ / VCH, ch_ = c_ % VCH; *(LAS u32x4*)(lds + OFF_V + (buf) * VT + row_ * VP + ch_ * 16) = vreg[i_]; } } } while (0)
#define ATT_DMA(j, buf) do { if constexpr (DMA) { const char* kt_ = (const char*)(Kp + (size_t)(j) * 64 * ldkv); const char* vt_ = (const char*)(Vp + (size_t)(j) * 64 * ldkv); \
        _Pragma("unroll") for (int ii = 0; ii < 2; ++ii) { \
            __builtin_amdgcn_global_load_lds((const unsigned*)(kt_ + dko[ii]), (LAS unsigned*)(lds + OFF_K + (buf) * KT + (2 * wave + ii) * 1024), 16, 0, 0); \
            __builtin_amdgcn_global_load_lds((const unsigned*)(vt_ + dvo[ii]), (LAS unsigned*)(lds + OFF_V + (buf) * VT + (2 * wave + ii) * 1024), 16, 0, 0); } } } while (0)
    ATT_LOAD(0); ATT_WRITE(0); ATT_DMA(0, 0);
    __syncthreads();
    for (int j = 0; j < ntiles; ++j) {
        if (j + 1 < ntiles) { ATT_LOAD(j + 1); ATT_DMA(j + 1, (j + 1) & 1); }
        if (j <= my_last) {
            const LAS unsigned char* kb = lds + OFF_K + (j & 1) * KT + r32 * KP + (DMA ? 0 : hi * 16);
            const int qv4 = (lane & 15) >> 2;
            const LAS unsigned char* vb = lds + OFF_V + (j & 1) * VT + (4 * hi + qv4) * VP + (16 * ((lane >> 4) & 1) + 4 * (lane & 3)) * 2;
            f32x16 sc0[NMAPS], sc1[NMAPS];
#pragma unroll
            for (int m = 0; m < NMAPS; ++m) {
                { const float z = zero_v();
#pragma unroll
                for (int r = 0; r < 16; ++r) { sc0[m][r] = z; sc1[m][r] = z; } }
#pragma unroll
                for (int d0 = 0; d0 < 4; ++d0) {
                    const int co = DMA ? (((m * 8 + d0 * 2 + hi) ^ xsw) << 4) : (m * 128 + d0 * 32);
                    const bf16x8 k0 = *(const LAS bf16x8*)(kb + co);
                    const bf16x8 k1 = *(const LAS bf16x8*)(kb + 32 * KP + co);
                    bf16x8 qv; if constexpr (QLDS) qv = *(const LAS bf16x8*)(qb_ + co); else qv = qf[m][d0];
                    sc0[m] = __builtin_amdgcn_mfma_f32_32x32x16_bf16(k0, qv, sc0[m], 0, 0, 0);
                    sc1[m] = __builtin_amdgcn_mfma_f32_32x32x16_bf16(k1, qv, sc1[m], 0, 0, 0);
                }
            }
#pragma unroll
            for (int m = 0; m < NMAPS; ++m) {
                f32x16& s0 = sc0[m]; f32x16& s1 = sc1[m]; bf16x8 pf[4];
                float bfar = 0.f;
                if (DIFF) {
                    if (64 * j + 63 - (q0 + 32 * wave) <= -91) bfar = btab[0];
                    else {
                        const int relb = 64 * j + 4 * hi - qpos + 192;
#pragma unroll
                        for (int r = 0; r < 16; ++r) { const int ix = relb + (r & 3) + 8 * (r >> 2); s0[r] += btab[ix]; s1[r] += btab[ix + 32]; }
                    }
                }
                float mx = fmaxf(fmaxf(s0[0], s0[1]), s1[0]), mx2 = fmaxf(fmaxf(s0[2], s0[3]), s1[1]);
                mx = fmaxf(fmaxf(mx, s1[2]), s1[3]);
#pragma unroll
                for (int r = 4; r < 16; r += 4) { mx = fmaxf(fmaxf(mx, s0[r]), s0[r + 1]); mx2 = fmaxf(fmaxf(mx2, s0[r + 2]), s0[r + 3]); mx = fmaxf(fmaxf(mx, s1[r]), s1[r + 1]); mx2 = fmaxf(fmaxf(mx2, s1[r + 2]), s1[r + 3]); }
                mx = fmaxf(mx, mx2);
                mx = fmaxf(mx, __shfl_xor(mx, 32)) + bfar;
                const float mnew = fmaxf(mrun[m], mx);
                const float alpha = __builtin_amdgcn_exp2f(mrun[m] - mnew);
                mrun[m] = mnew;
                const float cref = mnew - bfar;
                float rs = 0.f, rs2 = 0.f;
#pragma unroll
                for (int r = 0; r < 16; ++r) { s0[r] = __builtin_amdgcn_exp2f(s0[r] - cref); s1[r] = __builtin_amdgcn_exp2f(s1[r] - cref); rs += s0[r]; rs2 += s1[r]; }
                rs += rs2;
                rs += __shfl_xor(rs, 32);
                lrun[m] = lrun[m] * alpha + rs;
                if (__builtin_amdgcn_ballot_w64(alpha != 1.0f) != 0ull) {
                    sc[lane] = alpha;
#pragma unroll
                    for (int r = 0; r < 16; ++r) { const float f = sc[crow(r, hi)];
#pragma unroll
                        for (int d = 0; d < NDV; ++d) O[m][d][r] *= f; }
                }
                u32x4 w;
                w.x = pk2(s0[0], s0[1]); w.y = pk2(s0[2], s0[3]); w.z = pk2(s0[4], s0[5]); w.w = pk2(s0[6], s0[7]); pf[0] = __builtin_bit_cast(bf16x8, w);
                w.x = pk2(s0[8], s0[9]); w.y = pk2(s0[10], s0[11]); w.z = pk2(s0[12], s0[13]); w.w = pk2(s0[14], s0[15]); pf[1] = __builtin_bit_cast(bf16x8, w);
                w.x = pk2(s1[0], s1[1]); w.y = pk2(s1[2], s1[3]); w.z = pk2(s1[4], s1[5]); w.w = pk2(s1[6], s1[7]); pf[2] = __builtin_bit_cast(bf16x8, w);
                w.x = pk2(s1[8], s1[9]); w.y = pk2(s1[10], s1[11]); w.z = pk2(s1[12], s1[13]); w.w = pk2(s1[14], s1[15]); pf[3] = __builtin_bit_cast(bf16x8, w);
#pragma unroll
                for (int ks = 0; ks < 4; ++ks)
#pragma unroll
                    for (int d = 0; d < NDV; ++d) {
                        const int vo = DMA ? ((d ^ qv4) << 6) : d * 64;
                        const s16x4 lo = vtr(vb + (16 * ks) * VP + vo), hh = vtr(vb + (16 * ks + 8) * VP + vo);
                        const bf16x8 vf = (bf16x8){lo[0], lo[1], lo[2], lo[3], hh[0], hh[1], hh[2], hh[3]};
                        O[m][d] = __builtin_amdgcn_mfma_f32_32x32x16_bf16(pf[ks], vf, O[m][d], 0, 0, 0);
                    }
                __builtin_amdgcn_sched_barrier(0);
            }
        }
        if (j + 1 < ntiles) ATT_WRITE((j + 1) & 1);
        __syncthreads();
    }
#undef ATT_LOAD
#undef ATT_WRITE
#undef ATT_DMA
    int lane_e = lane; asm volatile("" : "+v"(lane_e));
    const int r32e = lane_e & 31, hie = lane_e >> 5;
    float a0[16], a1[16];
    sc[lane_e] = 1.0f / lrun[0];
#pragma unroll
    for (int r = 0; r < 16; ++r) a0[r] = sc[crow(r, hie)];
    if (NMAPS == 2) {
        sc[lane_e] = lam / lrun[NMAPS - 1];
#pragma unroll
        for (int r = 0; r < 16; ++r) a1[r] = sc[crow(r, hie)];
    }
#pragma unroll
    for (int d = 0; d < NDV; ++d)
#pragma unroll
        for (int r = 0; r < 16; ++r) O[0][d][r] = (NMAPS == 2) ? (O[0][d][r] * a0[r] - O[NMAPS - 1][d][r] * a1[r]) : O[0][d][r] * a0[r];
#define y O[0]
    if (DIFF) {
        float gg[NDV];
#pragma unroll
        for (int d = 0; d < NDV; ++d) gg[d] = subg[32 * d + r32e] * oscale;
#pragma unroll
        for (int r = 0; r < 16; ++r) {
            float ss = 0.f;
#pragma unroll
            for (int d = 0; d < NDV; ++d) ss += y[d][r] * y[d][r];
            ss += __shfl_xor(ss, 1); ss += __shfl_xor(ss, 2); ss += __shfl_xor(ss, 4); ss += __shfl_xor(ss, 8); ss += __shfl_xor(ss, 16);
            const float rstd = __builtin_amdgcn_rsqf(ss * (1.0f / DV) + EPS);
#pragma unroll
            for (int d = 0; d < NDV; ++d) y[d][r] *= rstd * gg[d];
        }
    }
#pragma unroll
    for (int r = 0; r < 16; ++r) {
        bf16_t* orow = Op + (size_t)(wave * 32 + crow(r, hie)) * ldo + r32e;
#pragma unroll
        for (int d = 0; d < NDV; ++d) {
            if constexpr (WT) { bf16_t* dp_ = orow + 32 * d; const unsigned hv_ = f2bf(y[d][r]); asm volatile("global_store_short %0, %1, off sc1" :: "v"(dp_), "v"(hv_) : "memory"); }
            else orow[32 * d] = (bf16_t)f2bf(y[d][r]);
        }
    }
#undef y
    __syncthreads();
}

__device__ __forceinline__ int rel_bucket(int rel) {
    const int n = rel < 0 ? -rel : rel; int b;
    if (n < 8) b = n; else { b = 8 + (n >= 12) + (n >= 16) + (n >= 23) + (n >= 32) + (n >= 46) + (n >= 64) + (n >= 91); }
    return (rel > 0 ? 16 : 0) + b;
}
__device__ __forceinline__ int swz128(int row, int cb) { return row * 128 + (cb ^ (((row >> 1) & 1) << 6)); }
constexpr int SSD_CS = 0, SSD_DTL = 2048;
__device__ __forceinline__ void unpack8(const u32x4 v, float (&f)[8]) { f[0] = bf_lo(v.x); f[1] = bf_hi(v.x); f[2] = bf_lo(v.y); f[3] = bf_hi(v.y); f[4] = bf_lo(v.z); f[5] = bf_hi(v.z); f[6] = bf_lo(v.w); f[7] = bf_hi(v.w); }


__device__ __forceinline__ void ssd_dt(const Frame& F, const ArgsV& args, int l, int tb, const float* DT) {
    LAS float* CS = (LAS float*)(F.lds + SSD_CS); LAS float* DTL = (LAS float*)(F.lds + SSD_DTL);
    const int h = F.wave, ll = F.lane;
    const float x = DT[(size_t)(tb + ll) * 8 + h] + args.in[14][l * 8 + h];
    const float dtv = fmaxf(x, 0.f) + log1pf(__expf(-fabsf(x)));
    const float A = -__expf(args.in[15][l * 8 + h]);
    float v = dtv * A;
#pragma unroll
    for (int o = 1; o < 64; o <<= 1) { const float n = __shfl_up(v, o); if (ll >= o) v += n; }
    CS[h * 64 + ll] = v; DTL[h * 64 + ll] = dtv;
}
constexpr int CONV_RUN = 8;
struct ConvRun { u32x4 x[CONV_RUN + 3]; f32x4 w[4][2]; f32x4 b[2]; };
__device__ __forceinline__ void conv_load(ConvRun& R, const ArgsV& args, int l, const bf16_t* proj, int tb, int r0, int spos0, int col0) {
    const float* cw = args.in[12] + (size_t)l * 4 * 768 + col0; const float* cb = args.in[13] + (size_t)l * 768 + col0;
#pragma unroll
    for (int k = 0; k < CONV_RUN + 3; ++k) { R.x[k] = (u32x4){0u, 0u, 0u, 0u}; if (spos0 - 3 + k >= 0) R.x[k] = *(const u32x4*)(proj + (size_t)(tb + r0 - 3 + k) * PC + PX + col0); }
#pragma unroll
    for (int j = 0; j < 4; ++j) { R.w[j][0] = *(const f32x4*)(cw + j * 768); R.w[j][1] = *(const f32x4*)(cw + j * 768 + 4); }
    R.b[0] = *(const f32x4*)cb; R.b[1] = *(const f32x4*)(cb + 4);
}
__device__ __forceinline__ void conv_row(const ConvRun& R, int i, float (&o)[8]) {
    o[0] = R.b[0][0]; o[1] = R.b[0][1]; o[2] = R.b[0][2]; o[3] = R.b[0][3]; o[4] = R.b[1][0]; o[5] = R.b[1][1]; o[6] = R.b[1][2]; o[7] = R.b[1][3];
#pragma unroll
    for (int j = 0; j < 4; ++j) { const u32x4 xv = R.x[i + j]; const f32x4 w0 = R.w[j][0], w1 = R.w[j][1];
        o[0] += w0[0] * bf_lo(xv.x); o[1] += w0[1] * bf_hi(xv.x); o[2] += w0[2] * bf_lo(xv.y); o[3] += w0[3] * bf_hi(xv.y);
        o[4] += w1[0] * bf_lo(xv.z); o[5] += w1[1] * bf_hi(xv.z); o[6] += w1[2] * bf_lo(xv.w); o[7] += w1[3] * bf_hi(xv.w); }
#pragma unroll
    for (int e = 0; e < 8; ++e) o[e] = siluf_(o[e]);
}
__device__ __forceinline__ u32x4 pack8(const float (&o)[8], float s) { u32x4 w; w.x = pk2(o[0] * s, o[1] * s); w.y = pk2(o[2] * s, o[3] * s); w.z = pk2(o[4] * s, o[5] * s); w.w = pk2(o[6] * s, o[7] * s); return w; }
__device__ __forceinline__ bf16x8 trfrag(const LAS unsigned char* tile, int row, int cb) {
    const s16x4 lo = vtr(tile + swz128(row, cb)), hh = vtr(tile + swz128(row + 4, cb));
    return (bf16x8){lo[0], lo[1], lo[2], lo[3], hh[0], hh[1], hh[2], hh[3]};
}
__device__ __forceinline__ bf16x8 trfrag8(const LAS unsigned char* tile, int row, int cb) {
    const s16x4 lo = vtr(tile + swz128(row, cb)), hh = vtr(tile + swz128(row + 8, cb));
    return (bf16x8){lo[0], lo[1], lo[2], lo[3], hh[0], hh[1], hh[2], hh[3]};
}

__device__ __forceinline__ void ssd_local(const Frame& F, const ArgsV& args, int l, int item) {
    constexpr int OFF_BS = 4096, OFF_XD = 4096 + 2 * 8192;
    const bf16_t* proj = (const bf16_t*)(args.ws + WS_PROJ); const float* DT = (const float*)(args.ws + WS_DT);
    bf16_t* STATES = (bf16_t*)(args.ws + WS_STATES); float* DEC = (float*)(args.ws + WS_DEC);
    const int b = item >> 5, c = item & 31, tb = b * SEQ + c * 64, lane = F.lane, hi = lane >> 5, r32 = lane & 31;
    const LAS float* CS = (const LAS float*)(F.lds + SSD_CS); const LAS float* DTL = (const LAS float*)(F.lds + SSD_DTL);
    ssd_dt(F, args, l, tb, DT);
    __syncthreads();
    {
        const int cg = F.tid & 127, rg = F.tid >> 7;
        bf16_t* xbcs = (bf16_t*)(args.ws + WS_H);
        if (cg < 96) {
            const int h = cg >> 3;
            float cs63 = 0.f; if (cg < 64) cs63 = CS[h * 64 + 63];
#pragma unroll 1
            for (int pass = 0; pass < 2; ++pass) {
                const int r0 = (rg + 4 * pass) * CONV_RUN;
                ConvRun R; conv_load(R, args, l, proj, tb, r0, c * 64 + r0, cg * 8);
#pragma unroll
                for (int i = 0; i < CONV_RUN; ++i) {
                    const int ll = r0 + i; float o[8]; conv_row(R, i, o);
                    *(u32x4*)(xbcs + (size_t)(tb + ll) * 768 + cg * 8) = pack8(o, 1.f);
                    if (cg < 64) { const float sc_ = DTL[h * 64 + ll] * __expf(cs63 - CS[h * 64 + ll]); *(LAS u32x4*)(F.lds + OFF_XD + h * 8192 + swz128(ll, (cg & 7) * 16)) = pack8(o, sc_); }
                    else if (cg < 80) { const int g = (cg - 64) >> 3; *(LAS u32x4*)(F.lds + OFF_BS + g * 8192 + swz128(ll, ((cg - 64) & 7) * 16)) = pack8(o, 1.f); }
                }
            }
        }
    }
    __syncthreads();
    {
        const int h = F.wave, g = h >> 2;
        const LAS unsigned char* xd = F.lds + OFF_XD + h * 8192; const LAS unsigned char* bs = F.lds + OFF_BS + g * 8192;
        const int q = (lane & 15) >> 2, cbl = (16 * ((lane >> 4) & 1) + 4 * (lane & 3)) * 2;
        f32x16 acc[2][2];
#pragma unroll
        for (int a = 0; a < 2; ++a)
#pragma unroll
            for (int n = 0; n < 2; ++n)
                { const float z = zero_v();
#pragma unroll
                for (int r = 0; r < 16; ++r) acc[a][n][r] = z; }
#pragma unroll
        for (int ks = 0; ks < 4; ++ks) {
            bf16x8 af[2], bf[2];
#pragma unroll
            for (int pb = 0; pb < 2; ++pb) { af[pb] = trfrag(xd, 16 * ks + 8 * hi + q, pb * 64 + cbl); bf[pb] = trfrag(bs, 16 * ks + 8 * hi + q, pb * 64 + cbl); }
#pragma unroll
            for (int pb = 0; pb < 2; ++pb)
#pragma unroll
                for (int nb = 0; nb < 2; ++nb) acc[pb][nb] = __builtin_amdgcn_mfma_f32_32x32x16_bf16(af[pb], bf[nb], acc[pb][nb], 0, 0, 0);
        }
        bf16_t* st = STATES + (size_t)((b * 32 + c) * 8 + h) * 4096;
#pragma unroll
        for (int pb = 0; pb < 2; ++pb)
#pragma unroll
            for (int nb = 0; nb < 2; ++nb)
#pragma unroll
                for (int r = 0; r < 16; ++r) st[(32 * pb + crow(r, hi)) * 64 + 32 * nb + r32] = (bf16_t)f2bf(acc[pb][nb][r]);
        if (lane == 0) DEC[(b * 32 + c) * 8 + h] = __expf(CS[h * 64 + 63]);
    }
    __syncthreads();
}
__device__ __forceinline__ void ssd_scan(const Frame& F, const ArgsV& args) {
    bf16_t* STATES = (bf16_t*)(args.ws + WS_STATES); const float* DEC = (const float*)(args.ws + WS_DEC);
    for (int gid = F.vcu * NTHR + F.tid; gid < 128 * 1024; gid += F.G * NTHR) {
        const int bh = gid >> 10, e4 = gid & 1023, b = bh >> 3, h = bh & 7;
        f32x4 hreg = {0.f, 0.f, 0.f, 0.f};
#pragma unroll 1
        for (int half = 0; half < 2; ++half) {
            u32x2 s[16]; float d[16];
#pragma unroll
            for (int cc = 0; cc < 16; ++cc) { const int c = half * 16 + cc; s[cc] = *(const u32x2*)(STATES + (size_t)((b * 32 + c) * 8 + h) * 4096 + e4 * 4); d[cc] = DEC[(b * 32 + c) * 8 + h]; }
#pragma unroll
            for (int cc = 0; cc < 16; ++cc) { const int c = half * 16 + cc;
                u32x2 w; w.x = pk2(hreg.x, hreg.y); w.y = pk2(hreg.z, hreg.w);
                *(u32x2*)(STATES + (size_t)((b * 32 + c) * 8 + h) * 4096 + e4 * 4) = w;
                const f32x4 sv = {bf_lo(s[cc].x), bf_hi(s[cc].x), bf_lo(s[cc].y), bf_hi(s[cc].y)};
                hreg = hreg * d[cc] + sv; }
        }
    }
}
__device__ __forceinline__ void ssd_out(const Frame& F, const ArgsV& args, int l, int item) {
    constexpr int OFF_BS = 4096, OFF_CS = OFF_BS + 2 * 9216, OFF_XS = OFF_CS + 2 * 9216;
    bf16_t* proj = (bf16_t*)(args.ws + WS_PROJ); const float* DT = (const float*)(args.ws + WS_DT);
    const bf16_t* STATES = (const bf16_t*)(args.ws + WS_STATES); float* SSQ = (float*)(args.ws + WS_SSQ);
    const int b = item >> 5, c = item & 31, tb = b * SEQ + c * 64, lane = F.lane, hi = lane >> 5, r32 = lane & 31;
    const LAS float* CS = (const LAS float*)(F.lds + SSD_CS); const LAS float* DTL = (const LAS float*)(F.lds + SSD_DTL);
    ssd_dt(F, args, l, tb, DT);
    __syncthreads();
    {
        const bf16_t* xbcs = (const bf16_t*)(args.ws + WS_H);
        u32x4 v[12];
#pragma unroll
        for (int i = 0; i < 12; ++i) { const int t_ = F.tid + i * NTHR, ll = t_ / 96, ch = t_ % 96; v[i] = *(const u32x4*)(xbcs + (size_t)(tb + ll) * 768 + ch * 8); }
#pragma unroll
        for (int i = 0; i < 12; ++i) { const int t_ = F.tid + i * NTHR, ll = t_ / 96, ch = t_ % 96;
            if (ch < 64) { const int h = ch >> 3; *(LAS u32x4*)(F.lds + OFF_XS + h * 8192 + swz128(ll, (ch & 7) * 16)) = v[i]; }
            else if (ch < 80) { const int g = (ch - 64) >> 3; *(LAS u32x4*)(F.lds + OFF_BS + g * 9216 + ll * 144 + ((ch - 64) & 7) * 16) = v[i]; }
            else { const int g = (ch - 80) >> 3; *(LAS u32x4*)(F.lds + OFF_CS + g * 9216 + ll * 144 + ((ch - 80) & 7) * 16) = v[i]; } }
    }
    __syncthreads();
    {
        const int h = F.wave, g = h >> 2;
        const LAS unsigned char* xs = F.lds + OFF_XS + h * 8192; const LAS unsigned char* bs = F.lds + OFF_BS + g * 9216; const LAS unsigned char* cs_t = F.lds + OFF_CS + g * 9216;
        const int q = (lane & 15) >> 2, cbl = (16 * ((lane >> 4) & 1) + 4 * (lane & 3)) * 2;
        const LAS float* csh = CS + h * 64; const LAS float* dth = DTL + h * 64;
        bf16x8 Mf[3][2];
#pragma unroll
        for (int blk = 0; blk < 3; ++blk) {
            const int sb = blk >> 1, lb = (blk + 1) >> 1;
            f32x16 xt;
            { const float z = zero_v();
#pragma unroll
            for (int r = 0; r < 16; ++r) xt[r] = z; }
#pragma unroll
            for (int ks = 0; ks < 4; ++ks) {
                const bf16x8 a = *(const LAS bf16x8*)(bs + (32 * sb + r32) * 144 + (16 * ks + 8 * hi) * 2);
                const bf16x8 bq = *(const LAS bf16x8*)(cs_t + (32 * lb + r32) * 144 + (16 * ks + 8 * hi) * 2);
                xt = __builtin_amdgcn_mfma_f32_32x32x16_bf16(a, bq, xt, 0, 0, 0);
            }
            const int lpos = 32 * lb + r32; const float csl = csh[lpos];
#pragma unroll
            for (int r = 0; r < 16; ++r) { const int s = 32 * sb + crow(r, hi); xt[r] = (s <= lpos) ? xt[r] * __expf(csl - csh[s]) * dth[s] : 0.f; }
            u32x4 w;
            w.x = pk2(xt[0], xt[1]); w.y = pk2(xt[2], xt[3]); w.z = pk2(xt[4], xt[5]); w.w = pk2(xt[6], xt[7]); Mf[blk][0] = __builtin_bit_cast(bf16x8, w);
            w.x = pk2(xt[8], xt[9]); w.y = pk2(xt[10], xt[11]); w.z = pk2(xt[12], xt[13]); w.w = pk2(xt[14], xt[15]); Mf[blk][1] = __builtin_bit_cast(bf16x8, w);
        }
        f32x16 acc[2][2];
#pragma unroll
        for (int a = 0; a < 2; ++a)
#pragma unroll
            for (int n = 0; n < 2; ++n)
                { const float z = zero_v();
#pragma unroll
                for (int r = 0; r < 16; ++r) acc[a][n][r] = z; }
        const bf16_t* hin = STATES + (size_t)((b * 32 + c) * 8 + h) * 4096;
#pragma unroll
        for (int ks = 0; ks < 4; ++ks) {
            bf16x8 cf[2], hf[2];
#pragma unroll
            for (int x = 0; x < 2; ++x) {
                cf[x] = *(const LAS bf16x8*)(cs_t + (32 * x + r32) * 144 + (16 * ks + 8 * hi) * 2);
                hf[x] = *(const bf16x8*)(hin + (32 * x + r32) * 64 + 16 * ks + 8 * hi);
            }
#pragma unroll
            for (int lb = 0; lb < 2; ++lb)
#pragma unroll
                for (int pb = 0; pb < 2; ++pb) acc[lb][pb] = __builtin_amdgcn_mfma_f32_32x32x16_bf16(cf[lb], hf[pb], acc[lb][pb], 0, 0, 0);
        }
#pragma unroll
        for (int lb = 0; lb < 2; ++lb)
#pragma unroll
            for (int r = 0; r < 16; ++r) { const float e = __expf(csh[32 * lb + crow(r, hi)]); acc[lb][0][r] *= e; acc[lb][1][r] *= e; }
#pragma unroll
        for (int blk = 0; blk < 3; ++blk) {
            const int sb = blk >> 1, lb = (blk + 1) >> 1;
#pragma unroll
            for (int s2 = 0; s2 < 2; ++s2)
#pragma unroll
                for (int pb = 0; pb < 2; ++pb) {
                    const bf16x8 xf = trfrag8(xs, 32 * sb + 16 * s2 + 4 * hi + q, pb * 64 + cbl);
                    acc[lb][pb] = __builtin_amdgcn_mfma_f32_32x32x16_bf16(Mf[blk][s2], xf, acc[lb][pb], 0, 0, 0);
                }
        }
        const float Dh = args.in[16][l * 8 + h];
        LAS unsigned char* ys = F.lds + OFF_XS + h * 8192;
#pragma unroll
        for (int lb = 0; lb < 2; ++lb)
#pragma unroll
            for (int r = 0; r < 16; ++r) {
                const int lpos = 32 * lb + crow(r, hi);
#pragma unroll
                for (int pb = 0; pb < 2; ++pb) {
                    LAS bf16_t* e = (LAS bf16_t*)(ys + swz128(lpos, (32 * pb + r32) * 2));
                    *e = (bf16_t)f2bf(acc[lb][pb][r] + Dh * bf2f(*e));
                }
            }
        {
            const size_t t = (size_t)(tb + lane);
            const bf16_t* zrow = proj + t * PC + PZ + h * 64; bf16_t* orow = proj + t * PC + PV + h * 64;
            u32x4 zv[8], yv[8];
#pragma unroll
            for (int k = 0; k < 8; ++k) zv[k] = *(const u32x4*)(zrow + 8 * k);
#pragma unroll
            for (int k = 0; k < 8; ++k) yv[k] = *(const LAS u32x4*)(ys + swz128(lane, 16 * k));
            float sq = 0.f;
#pragma unroll
            for (int k = 0; k < 8; ++k) { float yf[8], zf[8]; unpack8(yv[k], yf); unpack8(zv[k], zf); float of[8];
#pragma unroll
                for (int e = 0; e < 8; ++e) { of[e] = yf[e] * siluf_(zf[e]); sq += of[e] * of[e]; }
                *(u32x4*)(orow + 8 * k) = pack8(of, 1.f); }
            ((LAS float*)(F.lds + SSD_CS))[h * 64 + lane] = sq;
        }
    }
    __syncthreads();
    if (F.tid < 64) { const LAS float* q = (const LAS float*)(F.lds + SSD_CS) + F.tid; float t8 = 0.f;
#pragma unroll
        for (int hh = 0; hh < 8; ++hh) t8 += q[hh * 64];
        SSQ[(size_t)(tb + F.tid)] = __builtin_amdgcn_rsqf(t8 * (1.f / 512.f) + EPS); }
    __syncthreads();
}
template <int W>
__device__ __forceinline__ void pool_task(bf16_t* proj, int r0, int s0, int col) {
    constexpr int R = 8; u32x4 win[W - 1 + R];
#pragma unroll
    for (int k = 0; k < W - 1 + R; ++k) { const bool valid = (s0 - (W - 1) + k) >= 0; win[k] = (u32x4){0u, 0u, 0u, 0u}; if (valid) win[k] = *(const u32x4*)(proj + (size_t)(r0 - (W - 1) + k) * PC + PU + col); }
    float sum[8];
#pragma unroll
    for (int e = 0; e < 8; ++e) sum[e] = 0.f;
#pragma unroll
    for (int k = 0; k < W - 1; ++k) { float f[8]; unpack8(win[k], f);
#pragma unroll
        for (int e = 0; e < 8; ++e) sum[e] += f[e]; }
#pragma unroll
    for (int i = 0; i < R; ++i) {
        float cur[8], old[8]; unpack8(win[W - 1 + i], cur); unpack8(win[i], old);
        const int cnt = (s0 + i + 1) < W ? (s0 + i + 1) : W; const float inv = __builtin_amdgcn_rcpf((float)cnt);
        float o[8];
#pragma unroll
        for (int e = 0; e < 8; ++e) { sum[e] += cur[e]; o[e] = sum[e] * inv - cur[e]; sum[e] -= old[e]; }
        u32x4 w; w.x = pk2(o[0], o[1]); w.y = pk2(o[2], o[3]); w.z = pk2(o[4], o[5]); w.w = pk2(o[6], o[7]);
        *(u32x4*)(proj + (size_t)(r0 + i) * PC + PK + col) = w;
    }
}
__device__ __forceinline__ void pool_phase(const Frame& F, const ArgsV& args) {
    bf16_t* proj = (bf16_t*)(args.ws + WS_PROJ);
    const int gw = F.vcu * NWAVES + F.wave, NGW = F.G * NWAVES;
    for (int wt = gw; wt < (T / 32) * 4; wt += NGW) {
        const int rb = wt >> 2, g = wt & 3, r0 = rb * 32 + (F.lane >> 4) * 8, s0 = r0 & (SEQ - 1), col = g * 128 + (F.lane & 15) * 8;
        if (g == 0) pool_task<2>(proj, r0, s0, col); else if (g == 1) pool_task<4>(proj, r0, s0, col); else if (g == 2) pool_task<8>(proj, r0, s0, col); else pool_task<16>(proj, r0, s0, col);
    }
}
namespace pg8 {
struct BranchProb {
    static constexpr bool GATHER = false;
    const char* A; const char* Bt; unsigned ldb2; int G, c; unsigned* dctr;
    __device__ __forceinline__ bool next(int i, Unit& u) const { const int L = (i / 3) * G + c; if (L >= 1024) return false; tile_of(L, 128, 8, u.pm, u.pn); u.x0 = i % 3; u.x1 = 0; return true; }
    __device__ __forceinline__ const char* a_base(const Unit& u, int t) const { return A + (size_t)u.pm * 256 * (PC * 2) + (size_t)u.x0 * 1024 + (size_t)t * 128; }
    __device__ __forceinline__ unsigned a_off(const Unit&, int half, int R, int C) const { return (unsigned)(half * 128 + R) * (unsigned)(PC * 2) + (unsigned)C * 2u; }
    __device__ __forceinline__ const char* b_base(const Unit& u, int t) const { return Bt + (size_t)(u.x0 * 1024 + u.pn * 128) * 1024 + (size_t)t * 128; }
    __device__ __forceinline__ void a_ready(const Unit&, int) const {}
    __device__ __forceinline__ void done(const Unit& u, int lane) const { if (dctr && u.x0 == 2) pan_arrive(dctr + 16 * u.pm, lane); }
};
struct EpiBranch {
    static constexpr bool PERM = true, PROBE2 = false, WANTS_NEXT = true; static constexpr int ID = 3;
    bf16_t* proj; const float* ssq; const bf16_t* gates; f32x4 (&mg)[2][4][2]; u32x4 (&gvn)[4]; LAS float* rsl; bool wt; LAS unsigned char* lds;
    __device__ __forceinline__ const bf16_t* gate_ptr(const Unit& u, int wr, int wc, int fr, int fq) const {
        const int wco = 2 * (u.pn & 1) + (wc >> 1), bjo = wc & 1, tid_ = (wr * 4 + wco) * 64 + fq * 16 + fr;
        return gates + ((size_t)(u.pm * 12 + u.x0 * 4 + (u.pn >> 1)) * 65536) + bjo * 4096 + tid_ * 8;
    }
    __device__ __forceinline__ void load_half(const Unit& u, int ai, u32x4 (&dst)[4], int wr, int wc, int fr, int fq) const {
        const bf16_t* gt = gate_ptr(u, wr, wc, fr, fq);
#pragma unroll
        for (int m = 0; m < 4; ++m) dst[m] = __builtin_nontemporal_load((const u32x4*)(gt + (ai * 4 + m) * 8192));
    }
    __device__ __forceinline__ void prefetch_rows(const Unit& u, int wr, int wc, int fr, int fq) const {
        const int wid = wr * 4 + wc;
        if (wid < 4) __builtin_amdgcn_global_load_lds((const unsigned*)(ssq + (size_t)u.pm * BM + wid * 64 + fq * 16 + fr), (LAS unsigned*)(rsl + wid * 64), 4, 0, 0);
    }
    __device__ __forceinline__ LAS unsigned char* g1_lds(int wid) const { return lds + (wid < 4 ? 5 : 7) * HTB + (wid & 3) * 4096; }
    __device__ __forceinline__ void dma_half1(const Unit& u, int wr, int wc, int fr, int fq) const {
        const bf16_t* gt = gate_ptr(u, wr, wc, fr, fq); LAS unsigned char* dst = g1_lds(wr * 4 + wc);
#pragma unroll
        for (int m = 0; m < 4; ++m) __builtin_amdgcn_global_load_lds((const unsigned*)(gt + (4 + m) * 8192), (LAS unsigned*)(dst + m * 1024), 16, 0, 0);
    }
    __device__ __forceinline__ void prefetch(const Unit& u, int wr, int wc, int fr, int fq) const { load_half(u, 0, gvn, wr, wc, fr, fq); dma_half1(u, wr, wc, fr, fq); if (u.x0 == 2) prefetch_rows(u, wr, wc, fr, fq); }
    __device__ __forceinline__ void apply(const f32x4 (&acc)[2][1][4][2], const Unit& u, int ai, const u32x4 (&gv)[4], const float (&rq)[4], int wr, int wc, int fr, int fq) const {
        const int row0 = u.pm * BM + wr * 64, b = u.x0;
#pragma unroll
        for (int m = 0; m < 4; ++m) {
            const float r = rq[m];
            const u32x4 g4 = gv[m];
            float gg[8];
            gg[0] = bf_lo(g4.x); gg[1] = bf_hi(g4.x); gg[2] = bf_lo(g4.y); gg[3] = bf_hi(g4.y); gg[4] = bf_lo(g4.z); gg[5] = bf_hi(g4.z); gg[6] = bf_lo(g4.w); gg[7] = bf_hi(g4.w);
#pragma unroll
            for (int e = 0; e < 8; ++e) { const float v = acc[ai][0][m][e >> 2][e & 3] * r * sigmoidf_(gg[e]); mg[ai][m][e >> 2][e & 3] = (b == 0) ? v : mg[ai][m][e >> 2][e & 3] + v; }
            if (b == 2) {
                u32x4 w; const f32x4 m0 = mg[ai][m][0], m1 = mg[ai][m][1];
                w.x = pk2(m0[0], m0[1]); w.y = pk2(m0[2], m0[3]); w.z = pk2(m1[0], m1[1]); w.w = pk2(m1[2], m1[3]);
                bf16_t* dp_ = proj + (size_t)(row0 + ai * HALF + m * 16 + fr) * PC + PU + u.pn * 128 + wc * 32 + 8 * fq;
                if (wt) asm volatile("global_store_dwordx4 %0, %1, off sc1\n\ts_nop 1" :: "v"(dp_), "v"(w) : "memory");
                else __builtin_nontemporal_store(w, (u32x4*)dp_);
            }
        }
    }
    __device__ __forceinline__ void operator()(const f32x4 (&acc)[2][1][4][2], const Unit& u, const Unit& un, const bool has_next, int wr, int wc, int fr, int fq) const {
        const int b = u.x0;
        float rq[2][4];
#pragma unroll
        for (int ai = 0; ai < 2; ++ai)
#pragma unroll
            for (int m = 0; m < 4; ++m) rq[ai][m] = (b == 2) ? rsl[wr * 64 + ai * HALF + m * 16 + fr] : 1.f;
        if (has_next && un.x0 == 2) prefetch_rows(un, wr, wc, fr, fq);
        u32x4 g0[4], g1[4];
#pragma unroll
        for (int m = 0; m < 4; ++m) g0[m] = gvn[m];
        apply(acc, u, 0, g0, rq[0], wr, wc, fr, fq);
        { const LAS unsigned char* src = g1_lds(wr * 4 + wc) + (fq * 16 + fr) * 16;
#pragma unroll
          for (int m = 0; m < 4; ++m) g1[m] = *(const volatile LAS u32x4*)(src + m * 1024); }
        asm volatile("s_waitcnt lgkmcnt(0)" ::: "memory");
        if (has_next) { load_half(un, 0, gvn, wr, wc, fr, fq); dma_half1(un, wr, wc, fr, fq); }
        apply(acc, u, 1, g1, rq[1], wr, wc, fr, fq);
    }
};

struct MoeTab { const volatile LAS int* tb; };
__device__ __forceinline__ void pair_of(int pid, int& lo, int& hi) { lo = pid < 3 ? 0 : (pid < 5 ? 1 : 2); hi = pid < 3 ? pid + 1 : (pid < 5 ? pid - 1 : 3); }
struct MoeGuProb {
    static constexpr bool GATHER = true;
    const char* H; const char* Wgu; const int* list; unsigned ldb2; const volatile LAS int* tb; int G, c; unsigned* tcnt; const LAS int* toks;
    __device__ __forceinline__ bool next(int i, Unit& u) const {
        const int NT = tb[24], x = c & 7, y = c >> 3, q = NT >> 3, r = NT & 7, nx = q + (x < r ? 1 : 0), t0 = x * q + (x < r ? x : r);
        const int uu = y + (G >> 3) * i, k = uu >> 3; if (k >= nx) return false;
        const int tile = t0 + k;
        const int li = tb[64 + tile];
        u.pm = tile; u.pn = uu & 7; u.x0 = li; u.x1 = (tile - tb[li]) * 256; u.x2 = i; return true;
    }
    __device__ __forceinline__ const char* a_base(const Unit&, int t) const { return H + (size_t)t * 128; }
    __device__ __forceinline__ unsigned a_off(const Unit& u, int half, int R, int C) const {
        const int tok = toks[u.x2 * 256 + half * 128 + R];
        return (unsigned)tok * 2048u + (unsigned)C * 2u;
    }
    __device__ __forceinline__ const char* b_base(const Unit& u, int t) const {
        int lo, hi; pair_of(u.x0 % 6, lo, hi); const int e = (u.x0 / 6) * 4 + (u.pn < 4 ? lo : hi);
        return Wgu + (size_t)(e * 1024 + (u.pn & 3) * 256) * 2048 + (size_t)t * 128;
    }
    __device__ __forceinline__ void a_ready(const Unit&, int) const {}
    __device__ __forceinline__ void done(const Unit& u, int lane) const {
        asm volatile("s_waitcnt vmcnt(0)" ::: "memory");
        if (lane == 0) __hip_atomic_fetch_add(tcnt + 64 * u.pm, 1u, __ATOMIC_RELAXED, __HIP_MEMORY_SCOPE_AGENT);
    }
};
struct EpiGateUp {
    static constexpr bool PERM = true, PROBE2 = false, WANTS_NEXT = false; static constexpr int ID = 4;
    bf16_t* amoe; const LAS f32x2* lws; const LAS float* rsd;
    __device__ __forceinline__ void operator()(const f32x4 (&acc)[2][2][4][2], const Unit& u, int wr, int wc, int fr, int fq) const {
        const int rl0 = wr * 64 + fr, col0 = u.pn * 128 + wc * 32 + 8 * fq; const int which = u.pn >> 2;
#pragma unroll
        for (int ai = 0; ai < 2; ++ai)
#pragma unroll
            for (int m = 0; m < 4; ++m) {
                const int rl = rl0 + ai * HALF + m * 16;
                const f32x2 wv = lws[u.x2 * 256 + rl]; const float cw = which ? wv.y : wv.x;
                const float rr = MOE_FOLD ? rsd[u.x2 * 256 + rl] : 1.f;
                const f32x4 g0 = acc[ai][0][m][0] * rr, g1 = acc[ai][0][m][1] * rr, u0 = acc[ai][1][m][0] * rr, u1 = acc[ai][1][m][1] * rr;
                u32x4 w;
                w.x = pk2(siluf_(g0[0]) * u0[0] * cw, siluf_(g0[1]) * u0[1] * cw); w.y = pk2(siluf_(g0[2]) * u0[2] * cw, siluf_(g0[3]) * u0[3] * cw);
                w.z = pk2(siluf_(g1[0]) * u1[0] * cw, siluf_(g1[1]) * u1[1] * cw); w.w = pk2(siluf_(g1[2]) * u1[2] * cw, siluf_(g1[3]) * u1[3] * cw);
                { bf16_t* dp_ = amoe + (size_t)(u.pm * 256 + rl) * 1024 + col0;
                  asm volatile("global_store_dwordx4 %0, %1, off sc1\n\ts_nop 1" :: "v"(dp_), "v"(w) : "memory"); }
            }
    }
};
struct MoeDnProb {
    static constexpr bool GATHER = false;
    const char* A; const char* Wdn; unsigned ldb2; const volatile LAS int* tb; int G, c; const unsigned* tcnt; unsigned* tmo;
    __device__ __forceinline__ bool next(int i, Unit& u) const {
        const int NT = tb[24], x = c & 7, y = ((G >> 3) - 1) - (c >> 3), q = NT >> 3, r = NT & 7, nx = q + (x < r ? 1 : 0), t0 = x * q + (x < r ? x : r);
        const int uu = y + (G >> 3) * i, k = uu >> 2; if (k >= nx) return false;
        const int tile = t0 + k;
        const int li = tb[64 + tile];
        u.pm = tile; u.pn = uu & 3; u.x0 = li; u.x1 = (tile - tb[li]) * 256; u.x2 = i; return true;
    }
    __device__ __forceinline__ const char* a_base(const Unit& u, int t) const { return A + (size_t)u.pm * 256 * 2048 + (size_t)t * 128; }
    __device__ __forceinline__ unsigned a_off(const Unit&, int half, int R, int C) const { return (unsigned)(half * 128 + R) * 2048u + (unsigned)C * 2u; }
    __device__ __forceinline__ const char* b_base(const Unit& u, int t) const {
        int lo, hi; pair_of(u.x0 % 6, lo, hi); const int e = (u.x0 / 6) * 4 + (t < 8 ? lo : hi);
        return Wdn + (size_t)(e * 1024 + u.pn * 256) * 1024 + (size_t)(t & 7) * 128;
    }
    __device__ __forceinline__ void a_ready(const Unit& u, int tid) const {
        if (tid < 64) {
            unsigned polls = 0;
            while ((unsigned)__builtin_amdgcn_readfirstlane(__hip_atomic_load(tcnt + 64 * u.pm, __ATOMIC_RELAXED, __HIP_MEMORY_SCOPE_AGENT)) < 64u) {
                if (++polls > (1u << 22)) { if (tid == 0) __hip_atomic_store(tmo, 1u, __ATOMIC_RELAXED, __HIP_MEMORY_SCOPE_AGENT); break; }
                __builtin_amdgcn_s_sleep(2);
            }
            __builtin_amdgcn_fence(__ATOMIC_ACQUIRE, "agent");
            asm volatile("s_waitcnt vmcnt(0)" ::: "memory");
        }
        asm volatile("" ::: "memory"); __builtin_amdgcn_s_barrier(); asm volatile("" ::: "memory");
    }
    __device__ __forceinline__ void done(const Unit&, int) const {}
};
struct EpiDown {
    static constexpr bool PERM = true, PROBE2 = false, WANTS_NEXT = false; static constexpr int ID = 5;
    bf16_t* xb; const LAS int* toksd;
    __device__ __forceinline__ void operator()(const f32x4 (&acc)[2][2][4][2], const Unit& u, int wr, int wc, int fr, int fq) const {
        const int rl0 = wr * 64 + fr, col0 = u.pn * BM + wc * 64 + 8 * fq;
        int tok[2][4];
#pragma unroll
        for (int ai = 0; ai < 2; ++ai)
#pragma unroll
            for (int m = 0; m < 4; ++m) tok[ai][m] = toksd[u.x2 * 256 + rl0 + ai * HALF + m * 16];
#pragma unroll
        for (int ai = 0; ai < 2; ++ai) {
            u32x4 xo[4][2];
#pragma unroll
            for (int m = 0; m < 4; ++m)
#pragma unroll
                for (int bj = 0; bj < 2; ++bj) xo[m][bj] = *(const u32x4*)(xb + (size_t)(tok[ai][m] < 0 ? 0 : tok[ai][m]) * DM + col0 + bj * 32);
            asm volatile("" ::: "memory");
#pragma unroll
            for (int m = 0; m < 4; ++m) if (tok[ai][m] >= 0) {
#pragma unroll
                for (int bj = 0; bj < 2; ++bj) { const u32x4 o = xo[m][bj]; const f32x4 a0 = acc[ai][bj][m][0], a1 = acc[ai][bj][m][1]; u32x4 w;
                    w.x = pk2(bf_lo(o.x) + a0[0], bf_hi(o.x) + a0[1]); w.y = pk2(bf_lo(o.y) + a0[2], bf_hi(o.y) + a0[3]);
                    w.z = pk2(bf_lo(o.z) + a1[0], bf_hi(o.z) + a1[1]); w.w = pk2(bf_lo(o.w) + a1[2], bf_hi(o.w) + a1[3]);
                    *(u32x4*)(xb + (size_t)tok[ai][m] * DM + col0 + bj * 32) = w; }
            }
            asm volatile("" ::: "memory");
        }
    }
};
}

__device__ __forceinline__ float norm_store_r(const f32x4 (&xv)[4], const f32x4 (&gv)[4], bf16_t* orow, int lane) {
    float s = 0.f;
#pragma unroll
    for (int j = 0; j < 4; ++j) s += (xv[j].x * xv[j].x + xv[j].y * xv[j].y) + (xv[j].z * xv[j].z + xv[j].w * xv[j].w);
    const float rstd = 1.0f / sqrtf(wave_sum(s) * (1.f / DM) + EPS);
    unsigned long long* o8 = (unsigned long long*)orow + lane;
#pragma unroll
    for (int j = 0; j < 4; ++j) { const f32x4 hv = xv[j] * rstd * gv[j]; o8[64 * j] = (unsigned long long)pk2(hv.x, hv.y) | ((unsigned long long)pk2(hv.z, hv.w) << 32); }
    return rstd;
}
__device__ __forceinline__ void moe_route(const Frame& F, const ArgsV& args, int l, const unsigned* wctr) {
    constexpr int OFF_W = 0, OFF_LG = 131072, OFF_CNT = 147968, OFF_BASE = 148096, OFF_REC = 148224;
    static_assert(OFF_REC + 128 * 16 + 512 <= RING_BYTES, "router LDS map");
    LAS float* W = (LAS float*)(F.lds + OFF_W); volatile LAS int* lcnt = (volatile LAS int*)(F.lds + OFF_CNT); volatile LAS int* lbase = (volatile LAS int*)(F.lds + OFF_BASE);
    LAS int* rec = (LAS int*)(F.lds + OFF_REC); LAS float* recr = (LAS float*)(F.lds + OFF_REC + 2048);   LAS float* lgs = (LAS float*)(F.lds + OFF_LG) + F.wave * (16 * 33);
    const float* wrg = args.in[27] + (size_t)l * DM * 4; const float* wre = args.in[29] + (size_t)l * DM * 16;
    const float* brg = args.in[28] + l * 4; const float* bre = args.in[30] + l * 16;
    const float* g = args.in[26] + (size_t)l * DM;
    const bf16_t* x = (const bf16_t*)(args.ws + WS_XB); bf16_t* H = (bf16_t*)(args.ws + WS_H);
    int* list = (int*)(args.ws + WS_LIST); f32x2* lw = (f32x2*)(args.ws + WS_LW);
    unsigned* gcnt = (unsigned*)(args.ws + WS_CTL) + CW_CNT + l * 32;
    const int lane = F.lane, ri = lane & 15, kq = lane >> 4;
    const int m0 = F.vcu * 128 + F.wave * 16;
    f32x4 gv[4]; load_gain(g, lane, gv);
    {
        const int kk = lane >> 2, jq = lane & 3;
        f32x4 we[8], wg_[8]; float gk[8];
#pragma unroll
        for (int it = 0; it < 8; ++it) { const int k = (it * NWAVES + F.wave) * 16 + kk; we[it] = *(const f32x4*)(wre + (size_t)k * 16 + 4 * jq); wg_[it] = *(const f32x4*)(wrg + (size_t)k * 4); gk[it] = g[k]; }
#pragma unroll
        for (int it = 0; it < 8; ++it) { const int k = (it * NWAVES + F.wave) * 16 + kk;
            const int idx = (((k >> 5) * 8 + (k & 7)) * 4 + ((k >> 3) & 3)) * 32 + 8 * jq;
            const f32x4 ge = we[it] * gk[it]; const f32x4 gg = (jq == 0) ? wg_[it] * gk[it] : (f32x4){0.f, 0.f, 0.f, 0.f};
            *(LAS f32x4*)(W + idx) = (f32x4){ge.x, gg.x, ge.y, gg.y}; *(LAS f32x4*)(W + idx + 4) = (f32x4){ge.z, gg.z, ge.w, gg.w}; }
    }
    if (F.tid < 24) lcnt[F.tid] = 0;
    if (wctr) pan_wait(wctr, 32u, F.tid, (unsigned*)(args.ws + WS_CTL) + 2);
    __syncthreads();
    float rs = 0.f;
    f32x4 acc0 = (f32x4){0.f, 0.f, 0.f, 0.f}, acc1 = (f32x4){0.f, 0.f, 0.f, 0.f};
    auto norm_pass = [&]() {
        u32x2 r0[4], r1[4], r2[4]; f32x4 cur[4];
#pragma unroll
        for (int j = 0; j < 4; ++j) { r0[j] = ((const u32x2*)(x + (size_t)m0 * DM) + lane)[64 * j]; r1[j] = ((const u32x2*)(x + (size_t)(m0 + 1) * DM) + lane)[64 * j]; }
#pragma unroll 1
        for (int i = 0; i < 16; ++i) {
            const int rn = i + 2 < 16 ? i + 2 : 15;
#pragma unroll
            for (int j = 0; j < 4; ++j) r2[j] = ((const u32x2*)(x + (size_t)(m0 + rn) * DM) + lane)[64 * j];
#pragma unroll
            for (int j = 0; j < 4; ++j) cur[j] = (f32x4){bf_lo(r0[j].x), bf_hi(r0[j].x), bf_lo(r0[j].y), bf_hi(r0[j].y)};
            const float rstd = norm_store_r(cur, gv, H + (size_t)(m0 + i) * DM, lane);
            rs = (lane == i) ? rstd : rs;
#pragma unroll
            for (int j = 0; j < 4; ++j) { r0[j] = r1[j]; r1[j] = r2[j]; }
        }
    };
    auto mfma_pass = [&]() {
        const bf16_t* xr = x + (size_t)(m0 + ri) * DM + kq * 8;
        const LAS float* wb = W + kq * 32 + 2 * ri;
        u32x4 xa[8], xn[8];
#pragma unroll
        for (int q = 0; q < 8; ++q) xa[q] = *(const u32x4*)(xr + q * 32);
#pragma unroll 1
        for (int c = 0; c < 32; c += 8) {
            const int cn = c + 8 < 32 ? c + 8 : c;
#pragma unroll
            for (int q = 0; q < 8; ++q) xn[q] = *(const u32x4*)(xr + (cn + q) * 32);
#pragma unroll
            for (int q = 0; q < 8; ++q) {
                const unsigned wds[4] = {xa[q].x, xa[q].y, xa[q].z, xa[q].w};
#pragma unroll
                for (int e = 0; e < 8; ++e) {
                    const float a = (e & 1) ? bf_hi(wds[e >> 1]) : bf_lo(wds[e >> 1]);
                    const f32x2 bw = *(const LAS f32x2*)(wb + ((c + q) * 8 + e) * 128);
                    acc0 = __builtin_amdgcn_mfma_f32_16x16x4f32(a, bw.x, acc0, 0, 0, 0);
                    acc1 = __builtin_amdgcn_mfma_f32_16x16x4f32(a, bw.y, acc1, 0, 0, 0);
                }
            }
#pragma unroll
            for (int q = 0; q < 8; ++q) xa[q] = xn[q];
        }
    };
    if (MOE_FOLD) {
        if (lane < 16) {
            const f32x4* sp = (const f32x4*)((const float*)(args.ws + WS_SSQ2) + (size_t)(m0 + lane) * 16);
            const f32x4 a = sp[0], b4 = sp[1], c4 = sp[2], d4 = sp[3];
            const float ssum = ((a.x + a.y) + (a.z + a.w)) + ((b4.x + b4.y) + (b4.z + b4.w)) + ((c4.x + c4.y) + (c4.z + c4.w)) + ((d4.x + d4.y) + (d4.z + d4.w));
            rs = 1.0f / sqrtf(ssum * (1.f / DM) + EPS);
        }
        mfma_pass();
    } else if (F.wave < 4) { norm_pass(); mfma_pass(); } else { mfma_pass(); norm_pass(); }
#pragma unroll
    for (int r = 0; r < 4; ++r) { lgs[(4 * kq + r) * 33 + ri] = acc0[r]; lgs[(4 * kq + r) * 33 + 16 + ri] = acc1[r]; }
    LDS_WAIT(); asm volatile("" ::: "memory");
    if (lane < 16) {
        const LAS float* lr = lgs + lane * 33;
        float gl[4]; float gm = -INFINITY; int gi = 0;
#pragma unroll
        for (int j = 0; j < 4; ++j) { gl[j] = lr[16 + j] * rs + brg[j]; if (gl[j] > gm) { gm = gl[j]; gi = j; } }
        float gs = 0.f;
#pragma unroll
        for (int j = 0; j < 4; ++j) gs += __expf(gl[j] - gm);
        const float g_p = 1.0f / gs;
        float el[4];
#pragma unroll
        for (int j = 0; j < 4; ++j) el[j] = lr[gi * 4 + j] * rs + bre[gi * 4 + j];
        int e0 = 0; float v0 = el[0];
#pragma unroll
        for (int j = 1; j < 4; ++j) if (el[j] > v0) { v0 = el[j]; e0 = j; }
        int e1 = -1; float v1 = -INFINITY;
#pragma unroll
        for (int j = 0; j < 4; ++j) if (j != e0 && el[j] > v1) { v1 = el[j]; e1 = j; }
        const float w1 = __expf(v1 - v0), inv = 1.0f / (1.0f + w1);
        const float c0 = g_p * inv, c1 = g_p * w1 * inv;
        const int lo = e0 < e1 ? e0 : e1, hi_e = e0 < e1 ? e1 : e0;
        const int pid = lo == 0 ? hi_e - 1 : (lo == 1 ? hi_e + 1 : 5);
        const int li = gi * 6 + pid;
        const int slot = __hip_atomic_fetch_add((LAS int*)&lcnt[li], 1, __ATOMIC_RELAXED, __HIP_MEMORY_SCOPE_WORKGROUP);
        const int rr = F.wave * 16 + lane;
        rec[rr * 4 + 0] = li; rec[rr * 4 + 1] = slot; rec[rr * 4 + 2] = __float_as_int(e0 < e1 ? c0 : c1); rec[rr * 4 + 3] = __float_as_int(e0 < e1 ? c1 : c0);
        recr[rr] = rs;
    }
    __syncthreads();
    if (F.tid < 24) { const int n = lcnt[F.tid]; lbase[F.tid] = n ? (int)atomicAdd(&gcnt[F.tid], (unsigned)n) : 0; }
    __syncthreads();
    if (F.tid < 128) {
        const int li = rec[F.tid * 4 + 0], slot = lbase[li] + rec[F.tid * 4 + 1];
        const int m = F.vcu * 128 + F.tid;
        list[(size_t)li * T + slot] = m;
        lw[(size_t)li * T + slot] = (f32x2){__int_as_float(rec[F.tid * 4 + 2]), __int_as_float(rec[F.tid * 4 + 3])};
        if (MOE_FOLD) ((float*)(args.ws + WS_LRS))[(size_t)li * T + slot] = recr[F.tid];
    }
    __syncthreads();
}
__device__ __forceinline__ void moe_table(const Frame& F, const ArgsV& args, int l, volatile LAS int* tb) {
    const unsigned* gcnt = (const unsigned*)(args.ws + WS_CTL) + CW_CNT + l * 32;
    if (F.tid < 24) tb[32 + F.tid] = (int)__hip_atomic_load(gcnt + F.tid, __ATOMIC_RELAXED, __HIP_MEMORY_SCOPE_AGENT);
    __syncthreads();
    if (F.tid == 0) { int acc = 0; for (int j = 0; j < 24; ++j) { tb[j] = acc; acc += (tb[32 + j] + 255) >> 8; } tb[24] = acc; }
    __syncthreads();
    if (F.tid < 160) { int li = 0; for (int j = 1; j < 24; ++j) li = (F.tid >= tb[j]) ? j : li; tb[64 + F.tid] = li; }
    __syncthreads();
}
template <class ProbG, class ProbD>
__device__ __forceinline__ void moe_stage(const Frame& F, const ProbG& P, const ProbD& D, const int* list, const f32x2* lw, const float* lrs, LAS int* toks, LAS f32x2* lws, LAS float* rsd, LAS int* toksd) {
    int v[3], vd[2]; f32x2 wv[3]; float rv[3];
    const int r = F.tid & 255;
#pragma unroll
    for (int p = 0; p < 3; ++p) {
        const int i = (F.tid >> 8) + 2 * p; pg8::Unit u; v[p] = 0; wv[p] = (f32x2){0.f, 0.f}; rv[p] = 0.f;
        if (i < 5 && P.next(i, u)) { const int cnt = P.tb[32 + u.x0]; if (u.x1 + r < cnt) { v[p] = list[(size_t)u.x0 * T + u.x1 + r]; wv[p] = lw[(size_t)u.x0 * T + u.x1 + r]; if (MOE_FOLD) rv[p] = lrs[(size_t)u.x0 * T + u.x1 + r]; } }
    }
#pragma unroll
    for (int p = 0; p < 2; ++p) {
        const int i = (F.tid >> 8) + 2 * p; pg8::Unit u; vd[p] = -1;
        if (i < 3 && D.next(i, u)) { const int cnt = D.tb[32 + u.x0]; if (u.x1 + r < cnt) vd[p] = list[(size_t)u.x0 * T + u.x1 + r]; }
    }
#pragma unroll
    for (int p = 0; p < 3; ++p) { const int i = (F.tid >> 8) + 2 * p; if (i < 5) { toks[i * 256 + r] = v[p]; lws[i * 256 + r] = wv[p]; rsd[i * 256 + r] = rv[p]; } }
#pragma unroll
    for (int p = 0; p < 2; ++p) { const int i = (F.tid >> 8) + 2 * p; if (i < 3) toksd[i * 256 + r] = vd[p]; }
    __syncthreads();
}
__device__ __forceinline__ void final_norm_row(const bf16_t* xrow, float* orow, const float* g, int lane) {
    const f32x4* gr = (const f32x4*)g + lane;
    f32x4 v[4]; float s = 0.f; load_row_b(xrow, lane, v);
#pragma unroll
    for (int j = 0; j < 4; ++j) { s += (v[j].x * v[j].x + v[j].y * v[j].y) + (v[j].z * v[j].z + v[j].w * v[j].w); }
    const float rstd = 1.0f / sqrtf(wave_sum(s) * (1.f / DM) + EPS);
#pragma unroll
    for (int j = 0; j < 4; ++j) { const f32x4 gg = gr[64 * j]; ((f32x4*)orow + lane)[64 * j] = v[j] * rstd * gg; }
}

constexpr int NPH = 14;
#ifndef NO_ROUTE_WAIT
#define NO_ROUTE_WAIT 0
#endif
#ifndef MERGE56
#define MERGE56 1
#endif
#ifndef MERGE910
#define MERGE910 1
#endif
#ifndef MERGE1011
#define MERGE1011 1
#endif
constexpr int NSTEPS = DEPTH * NPH + 1;
#ifndef EN_MIX
#define EN_MIX 1
#endif
#ifndef EN_XATTN
#define EN_XATTN 1
#endif
#ifndef EN_MOE
#define EN_MOE 1
#endif

__device__ __forceinline__ int launder(int v) { asm volatile("" : "+s"(v)); return v; }
__device__ __forceinline__ unsigned char* launder_p(unsigned char* p) { asm volatile("" : "+s"(p)); return p; }

__device__ __forceinline__ const AS4 unsigned char* launder_ka(const AS4 unsigned char* p) { asm volatile("" : "+s"(p)); return p; }

__global__ void __launch_bounds__(NTHR, 2) mega(Args kargs) {
    extern __shared__ __attribute__((aligned(16))) unsigned char lds_raw[];
    Frame F0;
    F0.lds = (LAS unsigned char*)lds_raw;
    F0.tid = threadIdx.x; F0.lane = F0.tid & 63; F0.wave = __builtin_amdgcn_readfirstlane(F0.tid >> 6);
    F0.G = gridDim.x; { const int bx = blockIdx.x; F0.vcu = (F0.G % 8 == 0) ? (bx % 8) * (F0.G / 8) + bx / 8 : bx; }
    volatile LAS unsigned* MISC = (volatile LAS unsigned*)(F0.lds + MISC_OFF);
    for (int u = F0.tid; u < (LDS_BYTES - MISC_OFF) / 4; u += NTHR) MISC[u] = 0u;
    __syncthreads();
    const int s_lo = kargs.s_lo, s_hi = kargs.s_hi;
    const bool use_bar = (s_hi - s_lo) > 1;
    XcdBarrier bar; bar.bar = (unsigned*)(kargs.ws + WS_CTL) + CW_BAR; bar.x = 0; bar.st = nullptr;
    if (use_bar) bar = xcd_barrier_post((unsigned*)(kargs.ws + WS_CTL) + CW_BAR, MISC + 8);
#ifndef ONLY_STEP
#define ONLY_STEP -1
#endif
#ifndef SKIP_STEP
#define SKIP_STEP -2
#endif
#ifndef STEP_MASK
#define STEP_MASK 0xffff
#endif
#define STEP_ON(p) ((ONLY_STEP < 0 || ONLY_STEP == (p)) && SKIP_STEP != (p) && ((STEP_MASK >> (p)) & 1))
#define IN(s) (launder(s_lo) <= (s) && (s) < launder(s_hi) && STEP_ON(((s) % NPH)))
#ifndef PROBE_T
#define PROBE_T -1
#endif
    unsigned long long tp_acc = 0ull, tp_prev = (PROBE_T >= 0) ? __builtin_amdgcn_s_memrealtime() : 0ull;
#define SEAM(s) do { if (IN(s) && IN((s) + 1)) { xcd_barrier(bar, F0.wave); if (REPS(16) == 2) xcd_barrier(bar, F0.wave); } \
    if (PROBE_T >= 0) { const unsigned long long tn_ = __builtin_amdgcn_s_memrealtime(); if (((s) % NPH) == PROBE_T) tp_acc += tn_ - tp_prev; tp_prev = tn_; } } while (0)
#define SEAM_IF(s, on) do { if ((on) && IN(s) && IN((s) + 1)) { xcd_barrier(bar, F0.wave); } \
    if (PROBE_T >= 0) { const unsigned long long tn_ = __builtin_amdgcn_s_memrealtime(); if (((s) % NPH) == PROBE_T) tp_acc += tn_ - tp_prev; tp_prev = tn_; } } while (0)
#ifndef REPEAT_STEP
#define REPEAT_STEP -1
#endif
#define REPS(p) ((REPEAT_STEP == (p)) ? 2 : 1)
#ifndef STAGGER13
#define STAGGER13 0
#endif
#define STAGGER(ticks) do { if ((ticks) > 0 && (bid & 1)) { const unsigned long long t0_ = __builtin_amdgcn_s_memrealtime(); while (__builtin_amdgcn_s_memrealtime() - t0_ < (unsigned long long)(ticks)) __builtin_amdgcn_s_sleep(8); } } while (0)
#define PHASE_VARS Frame F = F0; F.wave = launder(F0.wave); { unsigned ones_ = ~0u; asm volatile("" : "+s"(ones_)); F.lane = (int)__builtin_amdgcn_mbcnt_hi(ones_, __builtin_amdgcn_mbcnt_lo(ones_, 0u)); } F.tid = F.wave * 64 + F.lane; F.vcu = launder(F0.vcu); F.G = launder(F0.G); const int bid = launder((int)blockIdx.x); (void)bid; \
    const int l = launder(lraw); ArgsV args; args.in.ka = launder_ka((const AS4 unsigned char*)__builtin_amdgcn_kernarg_segment_ptr()); args.out = *(float* const AS4*)(args.in.ka + 280); args.ws = *(unsigned char* const AS4*)(args.in.ka + 288); unsigned char* ws = args.ws; unsigned char* wsw = ws + WS_W; float* out = args.out; \
    bf16_t* H = (bf16_t*)(ws + WS_H); bf16_t* MEMN = (bf16_t*)(ws + WS_MEMN); bf16_t* PROJ = (bf16_t*)(ws + WS_PROJ); \
    bf16_t* XB = (bf16_t*)(ws + WS_XB); (void)wsw; (void)H; (void)MEMN; (void)PROJ; (void)XB; (void)out

    for (int lraw = 0; lraw < DEPTH; ++lraw) {
        const int sb = lraw * NPH;
        if (IN(sb + 0)) {
            PHASE_VARS;
            const int gw = F.vcu * NWAVES + F.wave, NGW = F.G * NWAVES;
#ifdef PROBE_SUB0
            const unsigned long long ts0_ = __builtin_amdgcn_s_memrealtime();
#endif
            for (int rep = 0; rep < REPS(0); ++rep) prep_weights(F, args, l);
#ifdef PROBE_SUB0
            tp_acc += __builtin_amdgcn_s_memrealtime() - ts0_;
#endif
            for (int rep = 0; rep < REPS(15); ++rep) if (EN_MIX) {
                const bool heavy = gw < PREP_HEAVY;
                norm_rows_dt(F, args.in[0], XB, l == 0, args.in[20] + (size_t)l * DM, H, args.in[2] + (size_t)l * DM * IN_COLS, (float*)(ws + WS_DT),
                             heavy ? gw : PREP_HEAVY * 10 + (gw - PREP_HEAVY), heavy ? PREP_HEAVY : NGW - PREP_HEAVY, heavy ? PREP_HEAVY * 10 : T); }
            if (EN_XATTN) norm_rows_plain(F, args.in[1], args.in[22] + (size_t)l * DM, MEMN, BATCH * NMEM);
        }
        SEAM(sb + 0);
        if (IN(sb + 1)) {
            PHASE_VARS;
#ifndef PROBE_INPROJ
#define PROBE_INPROJ 0
#endif
            for (int rep = 0; rep < (PROBE_INPROJ ? 2 : REPS(1)); ++rep) if (EN_MIX) {
                const bool dm = PROBE_INPROJ && rep == 0;
#ifndef INPROJ_TAIL
#define INPROJ_TAIL 0
#endif
                pg8::PlainProb P{(const char*)H, (const char*)(wsw + W_IN), 2048u, 2048u, 128, 25, F.G, bid, (dm && (PROBE_INPROJ & 2)) ? 0 : 1, (dm && (PROBE_INPROJ & 4)) ? 0 : 1, INPROJ_TAIL ? 3072 : 0};
                LAS float* gb = (LAS float*)(F.lds + 131072);
                { const float* bsrc = args.in[3] + (size_t)l * 3072; float t6[6];
#pragma unroll
                  for (int i = 0; i < 6; ++i) t6[i] = bsrc[F.tid + i * NTHR];
#pragma unroll
                  for (int i = 0; i < 6; ++i) gb[F.tid + i * NTHR] = t6[i];
                  __syncthreads(); }
                pg8::EpiStore E{dm ? (bf16_t*)(ws + WS_STATES) : PROJ, dm ? 0 : PC, 13, gb, (bf16_t*)(ws + WS_GATE)};
#ifndef STAGGER_TICKS
#define STAGGER_TICKS 0
#endif
                if (STAGGER_TICKS > 0 && !dm) {
                    const unsigned long long t0 = __builtin_amdgcn_s_memrealtime(), dl = (unsigned long long)(((bid >> 3) & 7) * STAGGER_TICKS);
                    while (__builtin_amdgcn_s_memrealtime() - t0 < dl) __builtin_amdgcn_s_sleep(8);
                }
                pg8::gemm_phase<pg8::EpiStore, pg8::PlainProb, true>(F.lds, F.tid, P, E, 16);
                if (INPROJ_TAIL && !dm) {
                    pg8::HalfTailProb Tq{(const char*)H, (const char*)(wsw + W_IN), 2048u, 2048u, 128, 25, 3072, 256, F.G, bid};
                    pg8::EpiStoreH EH{PROJ, PC, 13, gb, (bf16_t*)(ws + WS_GATE)};
                    pg8::gemm_phase<pg8::EpiStoreH, pg8::HalfTailProb, true, 1>(F.lds, F.tid, Tq, EH, 16);
                }
            }
        }
        SEAM(sb + 1);
        if (IN(sb + 2) && EN_MIX) { PHASE_VARS; for (int it = F.vcu; it < 512 * REPS(2); it += F.G) ssd_local(F, args, l, it & 511); }
        SEAM(sb + 2);
        if (IN(sb + 3) && EN_MIX) {
            PHASE_VARS;
            ssd_scan(F, args);
            const float lam_init = 0.8f - 0.6f * __expf(-0.3f * (float)l);
            float lam;
            { float s1 = 0.f, s2 = 0.f; for (int i = 0; i < 64; ++i) { s1 += args.in[4][l * 64 + i] * args.in[5][l * 64 + i]; s2 += args.in[6][l * 64 + i] * args.in[7][l * 64 + i]; }
              lam = __expf(s1) - __expf(s2) + lam_init; }
            for (int it = F.vcu; it < 256; it += F.G) {
                const int bh = it >> 2, b = bh >> 2, h = bh & 3, sidx = it & 3;
                LAS float* btab = (LAS float*)(F.lds + attn_off_bt<2, 128, true>());
                if (F.tid < 256) btab[F.tid] = args.in[9][rel_bucket(F.tid - 192) * 4 + h] * LOG2E;
                __syncthreads();
                for (int rep = 0; rep < REPS(3); ++rep)
                for (int k = 0; k < 2; ++k) {
                    const int qb = k ? 7 - sidx : sidx, q0 = qb * 256;
                    const bf16_t* base = PROJ + (size_t)(b * SEQ) * PC;
                    const bool dummy = (REPS(3) == 2) && rep == 0;
                    attn_unit<2, 128, true>(F.lds, F.tid, base + (size_t)q0 * PC + PQ + h * 128, PC, base + PK + h * 128, base + PV + h * 128, PC,
                                            dummy ? H + (size_t)F.vcu * 1024 : PROJ + (size_t)(b * SEQ + q0) * PC + PQ + h * 128, dummy ? 0 : PC, q0 / 64 + 4, q0, lam, args.in[8] + (size_t)l * 128, 1.0f - lam_init);
                }
            }
        }
        SEAM(sb + 3);
        if (IN(sb + 4) && EN_MIX) {
            PHASE_VARS;
            for (int it = F.vcu; it < 512 * REPS(4); it += F.G) ssd_out(F, args, l, it & 511);
            for (int rep = 0; rep < REPS(14); ++rep) pool_phase(F, args);
        }
        SEAM(sb + 4);
        if (IN(sb + 5) && EN_MIX) {
            PHASE_VARS;
            pg8::BranchProb P{(const char*)PROJ, (const char*)(wsw + W_BR), 1024u, F.G, bid, MERGE56 ? pan_ctr(ws, l, 0, 0) : nullptr};
            f32x4 mg[2][4][2];
#pragma unroll
            for (int a = 0; a < 2; ++a)
#pragma unroll
                for (int m = 0; m < 4; ++m) { mg[a][m][0] = (f32x4){0.f, 0.f, 0.f, 0.f}; mg[a][m][1] = (f32x4){0.f, 0.f, 0.f, 0.f}; }
            u32x4 gvn[4];
            pg8::EpiBranch E{PROJ, (const float*)(ws + WS_SSQ), (const bf16_t*)(ws + WS_GATE), mg, gvn, (LAS float*)(F.lds + 131072), (bool)MERGE56, F.lds};
            { pg8::Unit u0; const int wid_ = F.tid >> 6, ln_ = F.tid & 63; if (P.next(0, u0)) E.prefetch(u0, wid_ >> 2, wid_ & 3, ln_ & 15, ln_ >> 4);
              else {
#pragma unroll
                  for (int m = 0; m < 4; ++m) gvn[m] = (u32x4){0u, 0u, 0u, 0u}; } }
            pg8::gemm_phase<pg8::EpiBranch, pg8::BranchProb, true, 1>(F.lds, F.tid, P, E, 8);
        }
        SEAM_IF(sb + 5, !MERGE56);
        if (IN(sb + 6) && EN_MIX) {
            PHASE_VARS;
            pg8::PlainProb P{(const char*)(PROJ + PU), (const char*)(wsw + W_MIX), (unsigned)(PC * 2), 2048u, 128, 4, F.G, bid, 1, 1, 0,
                             MERGE56 ? pan_ctr(ws, l, 0, 0) : nullptr, 64u, nullptr, (unsigned*)(ws + WS_CTL) + 2};
            pg8::EpiResidB<false> E{XB, XQ_FOLD ? (float*)(ws + WS_SSQ2) : nullptr};
#ifndef STAGGER6
#define STAGGER6 0
#endif
            STAGGER(STAGGER6);
            pg8::gemm_phase<pg8::EpiResidB<false>, pg8::PlainProb, true>(F.lds, F.tid, P, E, 16);
        }
        SEAM(sb + 6);
        if (XQ_FOLD && IN(sb + 8) && EN_XATTN) {
            PHASE_VARS;
            if (bid < 128) {
                int pm, pn; pg8::tile_of(bid, 128, 1, pm, pn);
                LAS float* rs = (LAS float*)(F.lds + 131072);
                if (F.tid < 256) {
                    const f32x4* sp = (const f32x4*)((const float*)(ws + WS_SSQ2) + (size_t)(pm * 256 + F.tid) * 16);
                    const f32x4 a = sp[0], b4 = sp[1], c4 = sp[2], d4 = sp[3];
                    const float ssum = ((a.x + a.y) + (a.z + a.w)) + ((b4.x + b4.y) + (b4.z + b4.w)) + ((c4.x + c4.y) + (c4.z + c4.w)) + ((d4.x + d4.y) + (d4.z + d4.w));
                    rs[F.tid] = 1.0f / sqrtf(ssum * (1.f / DM) + EPS);
                }
                __syncthreads();
                pg8::PlainProb P{(const char*)XB, (const char*)(wsw + W_XQ), 2048u, 2048u, 128, 1, F.G, bid};
                pg8::EpiStoreR E{(bf16_t*)(ws + WS_XQ), 256, rs};
                pg8::gemm_phase<pg8::EpiStoreR, pg8::PlainProb, true>(F.lds, F.tid, P, E, 16);
            } else if (bid < 160) {
                pg8::PlainProb P{(const char*)MEMN, (const char*)(wsw + W_XKV), 2048u, 2048u, 16, 2, 128, bid - 128};
                pg8::EpiStore E{(bf16_t*)(ws + WS_KV), 512, 1 << 30, nullptr, nullptr};
                pg8::gemm_phase<pg8::EpiStore, pg8::PlainProb, true>(F.lds, F.tid, P, E, 16);
            }
        }
        if (!XQ_FOLD && IN(sb + 8) && EN_XATTN) {
            PHASE_VARS;
            const int half = bid >> 7;
            int pm, pn; pg8::tile_of(bid & 127, 128, 1, pm, pn);
            unsigned* flag = (unsigned*)(ws + WS_CTL) + CW_F8 + (l * 128 + pm) * 16;
            {
                f32x4 gv[4], cur[4]; load_gain(args.in[21] + (size_t)l * DM, F.lane, gv);
                const int r0 = pm * 256 + half * 128 + F.wave * 16;
                u32x2 q0[4], q1[4], q2[4];
                load_raw_b(XB + (size_t)r0 * DM, F.lane, q0); load_raw_b(XB + (size_t)(r0 + 1) * DM, F.lane, q1);
#pragma unroll 1
                for (int i = 0; i < 16; ++i) {
                    const int rn = r0 + (i + 2 < 16 ? i + 2 : 15);
                    load_raw_b(XB + (size_t)rn * DM, F.lane, q2);
                    widen_b(q0, cur);
                    float s = 0.f;
#pragma unroll
                    for (int j = 0; j < 4; ++j) s += (cur[j].x * cur[j].x + cur[j].y * cur[j].y) + (cur[j].z * cur[j].z + cur[j].w * cur[j].w);
                    const float rstd = 1.0f / sqrtf(wave_sum(s) * (1.f / DM) + EPS);
                    unsigned long long* o8 = (unsigned long long*)(H + (size_t)(r0 + i) * DM) + F.lane;
#pragma unroll
                    for (int j = 0; j < 4; ++j) { const f32x4 hv = cur[j] * rstd * gv[j]; const unsigned long long w8 = (unsigned long long)pk2(hv.x, hv.y) | ((unsigned long long)pk2(hv.z, hv.w) << 32);
                        unsigned long long* dp_ = o8 + 64 * j;
                        asm volatile("global_store_dwordx2 %0, %1, off sc1" :: "v"(dp_), "v"(w8) : "memory"); }
#pragma unroll
                    for (int j = 0; j < 4; ++j) { q0[j] = q1[j]; q1[j] = q2[j]; }
                }
            }
            VM_WAIT();
            if (half == 1) {
                if (F.lane == 0) __hip_atomic_fetch_add(flag, 1u, __ATOMIC_RELAXED, __HIP_MEMORY_SCOPE_AGENT);
                if (bid < 160) {
                    pg8::PlainProb P{(const char*)MEMN, (const char*)(wsw + W_XKV), 2048u, 2048u, 16, 2, 128, bid - 128};
                    pg8::EpiStore E{(bf16_t*)(ws + WS_KV), 512, 1 << 30, nullptr, nullptr};
                    pg8::gemm_phase<pg8::EpiStore, pg8::PlainProb, true>(F.lds, F.tid, P, E, 16);
                }
            } else {
                if (F.tid < 64) {
                    unsigned polls = 0;
                    while ((unsigned)__builtin_amdgcn_readfirstlane(__hip_atomic_load(flag, __ATOMIC_RELAXED, __HIP_MEMORY_SCOPE_AGENT)) < 8u) {
                        if (++polls > (1u << 22)) { if (F.tid == 0) __hip_atomic_store((unsigned*)(ws + WS_CTL) + 2, 1u, __ATOMIC_RELAXED, __HIP_MEMORY_SCOPE_AGENT); break; }
                        __builtin_amdgcn_s_sleep(2);
                    }
                    __builtin_amdgcn_fence(__ATOMIC_ACQUIRE, "agent");
                    VM_WAIT();
                }
                __syncthreads();
                pg8::PlainProb P{(const char*)H, (const char*)(wsw + W_XQ), 2048u, 2048u, 128, 1, F.G, bid};
                pg8::EpiStore E{(bf16_t*)(ws + WS_XQ), 256, 1 << 30, nullptr, nullptr};
                pg8::gemm_phase<pg8::EpiStore, pg8::PlainProb, true>(F.lds, F.tid, P, E, 16);
            }
        }
        SEAM(sb + 8);
        if (IN(sb + 9) && EN_XATTN) {
            PHASE_VARS;
            for (int rep = 0; rep < REPS(9); ++rep)
            for (int it = F.vcu; it < 512; it += F.G) {
                const int b = it >> 5, h = (it >> 3) & 3, qb = it & 7;
                const bf16_t* XQ = (const bf16_t*)(ws + WS_XQ); bf16_t* XO = (bf16_t*)(ws + WS_XO); const bf16_t* KV = (const bf16_t*)(ws + WS_KV);
                attn_unit<1, 64, false, (bool)MERGE910>(F.lds, F.tid, XQ + (size_t)(b * SEQ + qb * 256) * 256 + h * 64, 256, KV + (size_t)(b * NMEM) * 512 + h * 64, KV + (size_t)(b * NMEM) * 512 + 256 + h * 64, 512,
                                        XO + (size_t)(b * SEQ + qb * 256) * 256 + h * 64, 256, 4, 0, 0.f, nullptr, 1.f);
                if (MERGE910) pan_arrive(pan_ctr(ws, l, 1, b * 8 + qb), F.lane);
            }
        }
        SEAM_IF(sb + 9, !MERGE910);
        if (IN(sb + 10) && EN_XATTN) {
            PHASE_VARS;
            pg8::PlainProb P{(const char*)(ws + WS_XO), (const char*)(wsw + W_XO), 512u, 512u, 128, 4, F.G, bid, 1, 1, 0,
                             MERGE910 ? pan_ctr(ws, l, 1, 0) : nullptr, 32u, MERGE1011 ? pan_ctr(ws, l, 2, 0) : nullptr, (unsigned*)(ws + WS_CTL) + 2};
            pg8::EpiResidB<(bool)MERGE1011> E{XB, MOE_FOLD ? (float*)(ws + WS_SSQ2) : nullptr};
#ifndef STAGGER10
#define STAGGER10 0
#endif
            STAGGER(STAGGER10);
            pg8::gemm_phase<pg8::EpiResidB<(bool)MERGE1011>, pg8::PlainProb, true>(F.lds, F.tid, P, E, launder(4));
        }
        SEAM_IF(sb + 10, !MERGE1011);
        if (IN(sb + 11) && EN_MOE) { PHASE_VARS; moe_route(F, args, l, (MERGE1011 && !NO_ROUTE_WAIT) ? pan_ctr(ws, l, 2, F.vcu >> 1) : nullptr); }
        SEAM(sb + 11);
        if (IN(sb + 13) && EN_MOE) {
            PHASE_VARS;
#ifdef PROBE_BUSY
            const unsigned long long tb0_ = __builtin_amdgcn_s_memrealtime();
#endif
            volatile LAS int* mtab = (volatile LAS int*)(F.lds + MISC_OFF + 256);
            moe_table(F, args, l, mtab);
            unsigned* tcnt = (unsigned*)(ws + WS_CTL) + CW_TILE + l * (160 * 64);
            LAS int* toks = (LAS int*)(F.lds + MISC_OFF + 2048);
            LAS f32x2* lws = (LAS f32x2*)(F.lds + 131072); LAS int* toksd = (LAS int*)(F.lds + 131072 + 10240);
            pg8::MoeGuProb P{(const char*)(MOE_FOLD ? XB : H), (const char*)(wsw + W_GU), (const int*)(ws + WS_LIST), 2048u, mtab, F.G, bid, tcnt, toks};
            pg8::MoeDnProb D{(const char*)(ws + WS_AMOE), (const char*)(wsw + W_DN), 1024u, mtab, F.G, bid, tcnt, (unsigned*)(ws + WS_CTL) + 2};
            LAS float* rsd = (LAS float*)(F.lds + 131072 + 10240 + 3072);
            moe_stage(F, P, D, (const int*)(ws + WS_LIST), (const f32x2*)(ws + WS_LW), (const float*)(ws + WS_LRS), toks, lws, rsd, toksd);
            {
                pg8::EpiGateUp E{(bf16_t*)(ws + WS_AMOE), lws, rsd};
                pg8::gemm_phase<pg8::EpiGateUp, pg8::MoeGuProb, true>(F.lds, F.tid, P, E, 16);
            }
            {
                pg8::EpiDown E{XB, toksd};
                STAGGER(STAGGER13);
                pg8::gemm_phase<pg8::EpiDown, pg8::MoeDnProb, true>(F.lds, F.tid, D, E, 16);
            }
#ifdef PROBE_BUSY
            if (bid == PROBE_BLK && F.tid == 0) *(volatile LAS unsigned long long*)(F.lds + MISC_OFF + 64) += __builtin_amdgcn_s_memrealtime() - tb0_;
#endif
        }
        SEAM(sb + 13);
    }
    if (IN(DEPTH * NPH)) {
        const int gw = F0.vcu * NWAVES + F0.wave, NGW = F0.G * NWAVES; float* out = kargs.out;
        const int lane_f = (int)__builtin_amdgcn_mbcnt_hi(~0u, __builtin_amdgcn_mbcnt_lo(~0u, 0u));
        const bf16_t* XBf = (const bf16_t*)(kargs.ws + WS_XB);
        f32x4 gg[4], v[4]; load_gain(kargs.in[34], lane_f, gg);
        u32x2 q0[4], q1[4], q2[4];
        load_raw_b(XBf + (size_t)gw * DM, lane_f, q0); load_raw_b(XBf + (size_t)(gw + NGW < T ? gw + NGW : gw) * DM, lane_f, q1);
#pragma unroll 1
        for (int m = gw; m < T; m += NGW) {
            const int m2 = (m + 2 * NGW < T) ? m + 2 * NGW : m;
            load_raw_b(XBf + (size_t)m2 * DM, lane_f, q2);
            widen_b(q0, v);
            float s = 0.f;
#pragma unroll
            for (int j = 0; j < 4; ++j) s += (v[j].x * v[j].x + v[j].y * v[j].y) + (v[j].z * v[j].z + v[j].w * v[j].w);
            const float rstd = 1.0f / sqrtf(wave_sum(s) * (1.f / DM) + EPS);
#pragma unroll
            for (int j = 0; j < 4; ++j) ((f32x4*)(out + (size_t)m * DM) + lane_f)[64 * j] = v[j] * rstd * gg[j];
#pragma unroll
            for (int j = 0; j < 4; ++j) { q0[j] = q1[j]; q1[j] = q2[j]; }
        }
    }
#ifndef PROBE_BLK
#define PROBE_BLK 0
#endif
#if defined(PROBE_GE) || defined(PROBE_R) || defined(PROBE_KL) || defined(PROBE_BUSY)
    if (blockIdx.x == PROBE_BLK && F0.wave == 0) { const unsigned long long acc_ = *(volatile LAS unsigned long long*)(F0.lds + MISC_OFF + 64); const unsigned long long t0 = __builtin_amdgcn_s_memrealtime(); while (__builtin_amdgcn_s_memrealtime() - t0 < acc_) __builtin_amdgcn_s_sleep(16); }
#endif
    if (PROBE_T >= 0 && blockIdx.x == 0) {
        const unsigned long long t0 = __builtin_amdgcn_s_memrealtime(); while (__builtin_amdgcn_s_memrealtime() - t0 < tp_acc) __builtin_amdgcn_s_sleep(16); }
#undef IN
#undef SEAM
}

extern "C" void kernel_launch(void* const* d_in, const int* in_sizes, int n_in, void* d_out, int out_size, void* d_ws, size_t ws_size, hipStream_t stream) {
    static int grid = 0;
    if (grid == 0) {
        if (n_in != 35 || out_size != T * DM || ws_size < WS_END) { fprintf(stderr, "kernel_launch: unexpected sizes n_in %d out %d ws %zu (need %zu)\n", n_in, out_size, ws_size, (size_t)WS_END); grid = -1; return; }
        int dev = 0, cus = 0, per_cu = 0;
        if (hipGetDevice(&dev) != hipSuccess || hipDeviceGetAttribute(&cus, hipDeviceAttributeMultiprocessorCount, dev) != hipSuccess) { grid = -1; return; }
        if (hipFuncSetAttribute((const void*)mega, hipFuncAttributeMaxDynamicSharedMemorySize, LDS_BYTES) != hipSuccess) { fprintf(stderr, "kernel_launch: hipFuncSetAttribute failed\n"); grid = -1; return; }
        if (hipOccupancyMaxActiveBlocksPerMultiprocessor(&per_cu, (const void*)mega, NTHR, LDS_BYTES) != hipSuccess || per_cu < 1) fprintf(stderr, "kernel_launch: occupancy query says %d\n", per_cu);
        (void)hipGetLastError();
        if (cus < 256) { fprintf(stderr, "kernel_launch: built for a 256-CU device, found %d CUs\n", cus); grid = -1; return; }
        grid = 256;
    }
    if (grid < 0) return;
    (void)hipMemsetAsync((char*)d_ws + WS_CTL, 0, CTL_BYTES, stream);
    Args a; memset(&a, 0, sizeof(a));
    for (int i = 0; i < 35; ++i) a.in[i] = (const float*)d_in[i];
    a.out = (float*)d_out; a.ws = (unsigned char*)d_ws;
#ifndef ONE_LAUNCH
#define ONE_LAUNCH 1
#endif
#if ONE_LAUNCH
    a.s_lo = 0; a.s_hi = NSTEPS;
    hipLaunchKernelGGL(mega, dim3(grid), dim3(NTHR), LDS_BYTES, stream, a);
#else
    for (int s = 0; s < NSTEPS; ++s) { a.s_lo = s; a.s_hi = s + 1; hipLaunchKernelGGL(mega, dim3(grid), dim3(NTHR), LDS_BYTES, stream, a); }
#endif
}
```
